# Optimizing an MI355X kernel written in HIP

```python
import jax, jax.numpy as jnp
from jax import lax
import numpy as np

D_MODEL = 1024
BATCH = 8
SEQ = 2048
DEPTH = 2

CHUNK = 64
EPS = 1e-6
LRU_WIDTH = D_MODEL
LRU_BLOCKS = 16
LRU_BLOCK_DIM = LRU_WIDTH // LRU_BLOCKS
LRU_CONV = 4
LRU_C = 8.0
RET_QK_DIM = 256
RET_V_DIM = 512
RET_HEADS = D_MODEL // RET_QK_DIM
RET_QK = RET_HEADS * RET_QK_DIM
RET_V = RET_HEADS * RET_V_DIM
ROPE_BASE = 10000.0
SC_WIDTH = D_MODEL
SC_CONV = 3
D_FF = 2816
SPLIT_SIZES = (LRU_WIDTH, LRU_WIDTH, RET_QK, RET_QK, RET_V, RET_V,
               SC_WIDTH, SC_WIDTH, SC_WIDTH, 3 * D_MODEL)
MIX_IN = sum(SPLIT_SIZES)

kernel_name = "hybrid_lru_retention_shortconv_macaron"


def rmsnorm(x, g):
    xf = x.astype(jnp.float32)
    xf = xf * lax.rsqrt(jnp.mean(xf * xf, axis=-1, keepdims=True) + EPS)
    return xf.astype(x.dtype) * g


def swiglu(u, w_in, w_out):
    gate, up = jnp.split(u @ w_in, 2, axis=-1)
    return (jax.nn.silu(gate) * up) @ w_out


def causal_depthwise_conv(x, w):
    K, C = w.shape
    return lax.conv_general_dilated(
        x, w[:, None, :].astype(x.dtype), window_strides=(1,), padding=[(K - 1, 0)],
        dimension_numbers=("NWC", "WIO", "NWC"), feature_group_count=C)


def _lin_rec_combine(e1, e2):
    a1, b1 = e1
    a2, b2 = e2
    return a1 * a2, a2 * b1 + b2


def rg_lru(x, w_a, b_a, w_x, b_x, lam):
    Bsz, S, W = x.shape
    xf = x.astype(jnp.float32)
    xb = xf.reshape(Bsz, S, LRU_BLOCKS, LRU_BLOCK_DIM)
    r = jax.nn.sigmoid(jnp.einsum("bsgi,gij->bsgj", xb, w_a.astype(jnp.float32)).reshape(Bsz, S, W)
                       + b_a.astype(jnp.float32))
    i = jax.nn.sigmoid(jnp.einsum("bsgi,gij->bsgj", xb, w_x.astype(jnp.float32)).reshape(Bsz, S, W)
                       + b_x.astype(jnp.float32))
    log_a = -LRU_C * r * jax.nn.softplus(-lam.astype(jnp.float32))
    a = jnp.exp(log_a)
    u = jnp.sqrt(-jnp.expm1(2.0 * log_a)) * (i * xf)
    _, h = lax.associative_scan(_lin_rec_combine, (a, u), axis=1)
    return h.astype(x.dtype)


def rope(t, positions):
    half = t.shape[-1] // 2
    inv_freq = jnp.power(ROPE_BASE, -jnp.arange(half, dtype=jnp.float32) / half)
    ang = positions.astype(jnp.float32)[:, None] * inv_freq[None, :]
    cos = jnp.cos(ang)[None, :, None, :]
    sin = jnp.sin(ang)[None, :, None, :]
    t1, t2 = t[..., :half], t[..., half:]
    return jnp.concatenate([t1 * cos - t2 * sin, t1 * sin + t2 * cos], axis=-1)


def retention(q, k, v, positions):
    Bsz, S, H, dk = q.shape
    dv = v.shape[-1]
    N = S // CHUNK
    q = rope(q.astype(jnp.float32), positions)
    k = rope(k.astype(jnp.float32), positions) * (dk ** -0.5)
    v = v.astype(jnp.float32)
    log_g = jnp.log1p(-jnp.power(2.0, -5.0 - jnp.arange(H, dtype=jnp.float32)))
    idx = jnp.arange(CHUNK, dtype=jnp.float32)
    intra_decay = jnp.exp(log_g[:, None, None] * jnp.abs(idx[:, None] - idx[None, :]))
    q_decay = jnp.exp(log_g[:, None] * (idx[None, :] + 1.0))
    k_decay = jnp.exp(log_g[:, None] * (CHUNK - 1.0 - idx[None, :]))
    chunk_decay = jnp.exp(log_g * CHUNK)

    def to_chunks(t):
        return t.reshape(Bsz, N, CHUNK, H, t.shape[-1]).transpose(1, 0, 3, 2, 4)

    qc, kc, vc = to_chunks(q), to_chunks(k), to_chunks(v)
    scores = jnp.einsum("nbhid,nbhjd->nbhij", qc, kc) * intra_decay
    intra = jnp.einsum("nbhij,nbhje->nbhie", scores, vc)

    def step(state, inp):
        qn, kn, vn = inp
        cross = jnp.einsum("bhid,bhde->bhie", qn, state) * q_decay[None, :, :, None]
        state = state * chunk_decay[None, :, None, None] + jnp.einsum(
            "bhjd,bhje->bhde", kn * k_decay[None, :, :, None], vn)
        return state, cross

    state0 = jnp.zeros((Bsz, H, dk, dv), jnp.float32)
    _, cross = lax.scan(step, state0, (qc, kc, vc))
    out = (intra + cross).transpose(1, 0, 3, 2, 4).reshape(Bsz, S, H, dv)
    out = out * lax.rsqrt(jnp.mean(out * out, axis=-1, keepdims=True) + EPS)
    return out


def hybrid_mixer(u, positions, w_in, lru_conv_w, lru_conv_b, lru_w_a, lru_b_a, lru_w_x, lru_b_x,
                 lru_lambda, w_lru_out, w_ret_out, sc_conv_w, w_sc_out, w_out):
    Bsz, S, _ = u.shape
    proj = u @ w_in
    cuts = [int(c) for c in np.cumsum(SPLIT_SIZES)[:-1]]
    xa, ya, q, k, v, g, sb, sc, sh, gates = jnp.split(proj, cuts, axis=-1)
    xa = causal_depthwise_conv(xa, lru_conv_w) + lru_conv_b
    ha = rg_lru(xa, lru_w_a, lru_b_a, lru_w_x, lru_b_x, lru_lambda)
    oa = (ha * jax.nn.gelu(ya)) @ w_lru_out
    ret = retention(q.reshape(Bsz, S, RET_HEADS, RET_QK_DIM),
                    k.reshape(Bsz, S, RET_HEADS, RET_QK_DIM),
                    v.reshape(Bsz, S, RET_HEADS, RET_V_DIM), positions)
    ob = (jax.nn.silu(g) * ret.reshape(Bsz, S, RET_V).astype(u.dtype)) @ w_ret_out
    oc = (sb * causal_depthwise_conv(sc * sh, sc_conv_w)) @ w_sc_out
    ga, gb, gc = jnp.split(jax.nn.sigmoid(gates), 3, axis=-1)
    return (ga * oa + gb * ob + gc * oc) @ w_out


def setup_inputs(seed: int = 0) -> dict:
    key = jax.random.key(seed)
    ks = jax.random.split(key, 32)
    L = DEPTH

    def nrm(k, shape, scale):
        return jax.random.normal(k, shape, jnp.float32) * scale

    def gain(k):
        return 1.0 + 0.02 * jax.random.normal(k, (L, D_MODEL), jnp.float32)

    a_target = jax.random.uniform(ks[2], (L, LRU_WIDTH), jnp.float32, minval=0.9, maxval=0.999)
    s = a_target ** (1.0 / LRU_C)
    lru_lambda = jnp.log(s) - jnp.log1p(-s)
    offset = CHUNK * jax.random.randint(ks[3], (), 0, 64, dtype=jnp.int32)
    return {
        "x": nrm(ks[0], (BATCH, SEQ, D_MODEL), 1.0),
        "positions": offset + jnp.arange(SEQ, dtype=jnp.int32),
        "ffn1_pre_g": gain(ks[4]),
        "ffn1_w_in": nrm(ks[5], (L, D_MODEL, 2 * D_FF), D_MODEL ** -0.5),
        "ffn1_w_out": nrm(ks[6], (L, D_FF, D_MODEL), D_FF ** -0.5),
        "ffn1_post_g": gain(ks[7]),
        "mix_pre_g": gain(ks[8]),
        "w_mix_in": nrm(ks[9], (L, D_MODEL, MIX_IN), D_MODEL ** -0.5),
        "lru_conv_w": nrm(ks[10], (L, LRU_CONV, LRU_WIDTH), LRU_CONV ** -0.5),
        "lru_conv_b": nrm(ks[11], (L, LRU_WIDTH), 0.01),
        "lru_w_a": nrm(ks[12], (L, LRU_BLOCKS, LRU_BLOCK_DIM, LRU_BLOCK_DIM), LRU_BLOCK_DIM ** -0.5),
        "lru_b_a": nrm(ks[13], (L, LRU_WIDTH), 0.01),
        "lru_w_x": nrm(ks[14], (L, LRU_BLOCKS, LRU_BLOCK_DIM, LRU_BLOCK_DIM), LRU_BLOCK_DIM ** -0.5),
        "lru_b_x": nrm(ks[15], (L, LRU_WIDTH), 0.01),
        "lru_lambda": lru_lambda,
        "w_lru_out": nrm(ks[16], (L, LRU_WIDTH, D_MODEL), LRU_WIDTH ** -0.5),
        "w_ret_out": nrm(ks[17], (L, RET_V, D_MODEL), RET_V ** -0.5),
        "sc_conv_w": nrm(ks[18], (L, SC_CONV, SC_WIDTH), SC_CONV ** -0.5),
        "w_sc_out": nrm(ks[19], (L, SC_WIDTH, D_MODEL), SC_WIDTH ** -0.5),
        "w_mix_out": nrm(ks[20], (L, D_MODEL, D_MODEL), D_MODEL ** -0.5),
        "mix_post_g": gain(ks[21]),
        "ffn2_pre_g": gain(ks[22]),
        "ffn2_w_in": nrm(ks[23], (L, D_MODEL, 2 * D_FF), D_MODEL ** -0.5),
        "ffn2_w_out": nrm(ks[24], (L, D_FF, D_MODEL), D_FF ** -0.5),
        "ffn2_post_g": gain(ks[25]),
    }


def reference(x, positions, ffn1_pre_g, ffn1_w_in, ffn1_w_out, ffn1_post_g, mix_pre_g, w_mix_in,
              lru_conv_w, lru_conv_b, lru_w_a, lru_b_a, lru_w_x, lru_b_x, lru_lambda, w_lru_out,
              w_ret_out, sc_conv_w, w_sc_out, w_mix_out, mix_post_g, ffn2_pre_g, ffn2_w_in,
              ffn2_w_out, ffn2_post_g):
    for l in range(DEPTH):
        h = swiglu(rmsnorm(x, ffn1_pre_g[l]), ffn1_w_in[l], ffn1_w_out[l])
        x = x + 0.5 * rmsnorm(h, ffn1_post_g[l])
        h = hybrid_mixer(rmsnorm(x, mix_pre_g[l]), positions, w_mix_in[l], lru_conv_w[l],
                         lru_conv_b[l], lru_w_a[l], lru_b_a[l], lru_w_x[l], lru_b_x[l],
                         lru_lambda[l], w_lru_out[l], w_ret_out[l], sc_conv_w[l], w_sc_out[l],
                         w_mix_out[l])
        x = x + rmsnorm(h, mix_post_g[l])
        h = swiglu(rmsnorm(x, ffn2_pre_g[l]), ffn2_w_in[l], ffn2_w_out[l])
        x = x + 0.5 * rmsnorm(h, ffn2_post_g[l])
    return x
```

```cpp
#include <hip/hip_runtime.h>
#include <hip/hip_cooperative_groups.h>
#include <cstdio>
#include <cstdint>
namespace cg = cooperative_groups;
#ifndef EN
#define EN 65535
#endif
namespace pg8 {
#define PG8_LAS __attribute__((address_space(3)))
typedef unsigned short bf16_t;
typedef short bf16x8 __attribute__((ext_vector_type(8)));
typedef float f32x4 __attribute__((ext_vector_type(4)));
typedef unsigned u32x4 __attribute__((ext_vector_type(4)));
constexpr int BM = 256, BK = 64, HALF = 128, HTB = HALF * BK * 2  , STAGE_BYTES = 8 * HTB, NXCD = 8, WGM = 8;

__host__ __device__ __forceinline__ int lds_byte(int r, int c) { const int st = (r >> 4) * 2 + (c >> 5), rr = r & 15, cc = c & 31, ob = rr * 64 + cc * 2; return st * 1024 + (ob ^ (((ob >> 9) & 1) << 5)); }
__host__ __device__ __forceinline__ void stage_rc(int b, int& R, int& C) { const int st = b / 1024, sb = b % 1024, swz = sb ^ (((sb >> 9) & 1) << 5); R = (st >> 1) * 16 + swz / 64; C = (st & 1) * 32 + (swz % 64) / 2; }
__host__ __device__ __forceinline__ int perm32(int rho) { const int n = rho >> 4, i = rho & 15; return 8 * (i >> 2) + 4 * n + (i & 3); }

struct Unit { int pm, pn; };
struct Gemm { const bf16_t* A; const bf16_t* Bt; int M, N, K; };

struct StaticOrder {
    int nM, nN, nwg, G, c;
    __host__ __device__ void init(int M, int N, int G_, int c_) { nM = M / BM; nN = N / BM; nwg = nM * nN; G = G_; c = c_; }
    __host__ __device__ bool next(int i, Unit& u) const {
        const long L = (long)i * G + c; if (L >= nwg) return false;
        int wgid = (int)L; { const int q = nwg / NXCD, r = nwg % NXCD, xcd = wgid % NXCD, off = wgid / NXCD; wgid = (xcd < r ? xcd * (q + 1) : r * (q + 1) + (xcd - r) * q) + off; }
        const int nig = WGM * nN, gid = wgid / nig, fm = gid * WGM, gsz = (nM - fm) < WGM ? (nM - fm) : WGM;
        u.pm = fm + ((wgid % nig) % gsz); u.pn = (wgid % nig) / gsz; return true;
    }
    __device__ __forceinline__ void a_ready(const Unit&) const {}
    __device__ __forceinline__ void done(const Unit&) const {}
};

__device__ __forceinline__ unsigned cvt_pk_bf16(float lo, float hi) { unsigned r; asm volatile("v_cvt_pk_bf16_f32 %0, %1, %2" : "=v"(r) : "v"(lo), "v"(hi)); return r; }
typedef float f32x2 __attribute__((ext_vector_type(2)));
__device__ __forceinline__ f32x2 gelu_pk(f32x2 v) {
    const f32x2 av = __builtin_elementwise_abs(v), d = av * 0.2316418882f + 1.0f;
    f32x2 t; t.x = __builtin_amdgcn_rcpf(d.x); t.y = __builtin_amdgcn_rcpf(d.y);
    f32x2 q = t * 0.5307027145f + (-0.7265760135f); q = q * t + 0.7107068705f; q = q * t + (-0.142248368f); q = q * t + 0.127414796f; q = q * t;
    const f32x2 s = (v * v) * (-0.72134752044f);
    f32x2 e; e.x = __builtin_amdgcn_exp2f(s.x); e.y = __builtin_amdgcn_exp2f(s.y);
    const f32x2 m = v * (q * e), r = v - m;
    f32x2 o; o.x = v.x < 0.f ? m.x : r.x; o.y = v.y < 0.f ? m.y : r.y; return o;
}

template <int ACT  > struct EpiBf16 {
    static constexpr bool PERM = true, AFTER_DRAIN = false; static_assert(ACT == 0 || ACT == 1, "EpiBf16: ACT is 0 (none) or 1 (gelu_pk)");
    bf16_t* O; int ldc; const float* bias; int split_cols; size_t split_stride; float scale0;
    __device__ __forceinline__ void operator()(const f32x4 (&acc)[2][2][4][2], const Unit& u, int wr, int wc, int fr, int fq) const {
        const int row0 = u.pm * BM + wr * 64 + fr; int colt = u.pn * BM; bf16_t* base = O;
        float sc = 1.f; if (split_cols) { const int t = colt / split_cols; base += (size_t)t * split_stride; colt -= t * split_cols; if (t == 0) sc = scale0; }
        const int col0 = colt + wc * 32 + 8 * fq, bcol0 = u.pn * BM + wc * 32 + 8 * fq;
        f32x4 bv[2][2];
#pragma unroll
        for (int bj = 0; bj < 2; ++bj)
#pragma unroll
            for (int n = 0; n < 2; ++n) bv[bj][n] = bias ? *(const f32x4*)(bias + bcol0 + bj * HALF + 4 * n) : (f32x4){0.f, 0.f, 0.f, 0.f};
#pragma unroll
        for (int ai = 0; ai < 2; ++ai)
#pragma unroll
            for (int m = 0; m < 4; ++m) { bf16_t* rowp = base + (size_t)(row0 + ai * HALF + m * 16) * ldc + col0;
#pragma unroll
                for (int bj = 0; bj < 2; ++bj) { f32x4 v0 = acc[ai][bj][m][0] + bv[bj][0], v1 = acc[ai][bj][m][1] + bv[bj][1];
                    if (ACT == 1) { f32x2 a = gelu_pk((f32x2){v0[0], v0[1]}), b = gelu_pk((f32x2){v0[2], v0[3]}), c = gelu_pk((f32x2){v1[0], v1[1]}), d = gelu_pk((f32x2){v1[2], v1[3]});
                        v0 = (f32x4){a.x, a.y, b.x, b.y}; v1 = (f32x4){c.x, c.y, d.x, d.y}; }
                    v0 = v0 * sc; v1 = v1 * sc; u32x4 w; w.x = cvt_pk_bf16(v0[0], v0[1]); w.y = cvt_pk_bf16(v0[2], v0[3]); w.z = cvt_pk_bf16(v1[0], v1[1]); w.w = cvt_pk_bf16(v1[2], v1[3]);
                    *(u32x4*)(rowp + bj * HALF) = w; } }
    }
};
template <class Epi, class Sched, bool ALIGN_EPI = false, bool SP2 = false>
__device__ __forceinline__ void gemm_phase(PG8_LAS unsigned char* lds, const Gemm g, const Sched& S, const Epi& E) {
    int tid_l = threadIdx.x; asm volatile("" : "+v"(tid_l));
    const int tid = tid_l, wid = __builtin_amdgcn_readfirstlane(tid >> 6), lane = tid & 63, wr = wid >> 2, wc = wid & 3, fr = lane & 15, fq = lane >> 4;
    const int K = g.K, nt = K / BK;
    unsigned voffA[2], voffB[2];
#pragma unroll
    for (int i = 0; i < 2; ++i) { int R, C; stage_rc(tid * 16 + i * 8192, R, C); const int Rb = Epi::PERM ? ((R & ~31) + perm32(R & 31)) : R;
        voffA[i] = (unsigned)(R * K + C) * 2u; voffB[i] = (unsigned)(Rb * K + C) * 2u; }
    const size_t kstep = (size_t)(BK * 2);
    const size_t hstep = (size_t)HALF * K * 2;
    const size_t tstep = 2 * hstep;
    const unsigned ldsw = (unsigned)wid * 1024u;
    const int aoff = lds_byte(wr * 64 + fr, fq * 8), boff = lds_byte(wc * 32 + fr, fq * 8);
#define PG8_SA(b, h) (((b) * 2 + (h)) * HTB)
#define PG8_SB(b, h) ((4 + (b) * 2 + (h)) * HTB)
#define PG8_STAGE(bufoff, gbase, voff) do { _Pragma("unroll") for (int _i = 0; _i < 2; ++_i) \
        __builtin_amdgcn_global_load_lds((const unsigned*)((const char*)(gbase) + (voff)[_i]), (PG8_LAS unsigned*)(lds + (bufoff) + ldsw + _i * 8192), 16, 0, 0); } while (0)
#define PG8_LDA(dst, b, h) do { _Pragma("unroll") for (int m = 0; m < 4; ++m) _Pragma("unroll") for (int k = 0; k < 2; ++k) dst[m][k] = *(const PG8_LAS bf16x8*)(lds + PG8_SA(b, h) + aoff + m * 2048 + k * 1024); } while (0)
#define PG8_LDB(dst, b, h) do { _Pragma("unroll") for (int n = 0; n < 2; ++n) _Pragma("unroll") for (int k = 0; k < 2; ++k) dst[n][k] = *(const PG8_LAS bf16x8*)(lds + PG8_SB(b, h) + boff + n * 2048 + k * 1024); } while (0)
#define PG8_MMA(ai, bj, At, Bt) do { __builtin_amdgcn_s_setprio(1); _Pragma("unroll") for (int m = 0; m < 4; ++m) _Pragma("unroll") for (int n = 0; n < 2; ++n) _Pragma("unroll") for (int k = 0; k < 2; ++k) \
        acc[ai][bj][m][n] = __builtin_amdgcn_mfma_f32_16x16x32_bf16(Bt[n][k], At[m][k], acc[ai][bj][m][n], 0, 0, 0); __builtin_amdgcn_s_setprio(0); } while (0)
#define PG8_WAIT_V(n) asm volatile("s_waitcnt vmcnt(" #n ")" ::: "memory")
#define PG8_WAIT_L(n) asm volatile("s_waitcnt lgkmcnt(" #n ")" ::: "memory")
#define PG8_BAR __builtin_amdgcn_s_barrier()
#define PG8_SCHED __builtin_amdgcn_sched_barrier(0)
    Unit cur, nxt; int ui = 0;
    if (!S.next(0, cur)) return;
    f32x4 acc[2][2][4][2];
#pragma unroll
    for (int a = 0; a < 2; ++a)
#pragma unroll
        for (int b = 0; b < 2; ++b)
#pragma unroll
            for (int m = 0; m < 4; ++m)
#pragma unroll
                for (int n = 0; n < 2; ++n) acc[a][b][m][n] = (f32x4){0.f, 0.f, 0.f, 0.f};
    bf16x8 At[4][2], B0[2][2], B1[2][2];
    const char* cA = (const char*)g.A + (size_t)cur.pm * tstep; const char* cB = (const char*)g.Bt + (size_t)cur.pn * tstep;
    S.a_ready(cur);
    if constexpr (SP2) {
        PG8_STAGE(PG8_SB(0, 0), cB, voffB); PG8_STAGE(PG8_SB(0, 1), cB + hstep, voffB); PG8_STAGE(PG8_SA(0, 0), cA, voffA); PG8_STAGE(PG8_SA(0, 1), cA + hstep, voffA);
        if (wr == 1) PG8_BAR;
        PG8_WAIT_V(2); PG8_BAR;
        PG8_STAGE(PG8_SB(1, 0), cB + kstep, voffB); PG8_STAGE(PG8_SA(1, 0), cA + kstep, voffA); PG8_STAGE(PG8_SB(1, 1), cB + hstep + kstep, voffB);
        PG8_WAIT_V(6); PG8_BAR;
    } else {
        PG8_STAGE(PG8_SB(0, 0), cB, voffB); PG8_STAGE(PG8_SA(0, 0), cA, voffA); PG8_STAGE(PG8_SB(0, 1), cB + hstep, voffB); PG8_STAGE(PG8_SA(0, 1), cA + hstep, voffA);
        if (wr == 1) PG8_BAR;
        PG8_WAIT_V(4); PG8_BAR;
        PG8_STAGE(PG8_SB(1, 0), cB + kstep, voffB); PG8_STAGE(PG8_SA(1, 0), cA + kstep, voffA); PG8_STAGE(PG8_SB(1, 1), cB + hstep + kstep, voffB);
        PG8_WAIT_V(6); PG8_BAR;
    }
    for (;;) {
        const bool has_next = S.next(ui + 1, nxt);
        const char* nA = has_next ? (const char*)g.A + (size_t)nxt.pm * tstep : cA; const char* nB = has_next ? (const char*)g.Bt + (size_t)nxt.pn * tstep : cB;
        for (int t = 0; t < nt; t += 2) {
            const bool last = (t == nt - 2);
            const char* a1 = cA + (size_t)(t + 1) * kstep;
            const char* a2 = last ? nA : cA + (size_t)(t + 2) * kstep; const char* b2 = last ? nB : cB + (size_t)(t + 2) * kstep;
            const char* a3 = a2 + kstep; const char* b3 = b2 + kstep;
            if (last && has_next) S.a_ready(nxt);
            if constexpr (SP2) {
            PG8_LDB(B0, 0, 0); PG8_LDB(B1, 0, 1); PG8_SCHED; PG8_LDA(At, 0, 0); PG8_STAGE(PG8_SA(1, 1), a1 + hstep, voffA);
            PG8_WAIT_V(8); PG8_WAIT_L(0); PG8_BAR; PG8_MMA(0, 0, At, B0); PG8_MMA(0, 1, At, B1); PG8_BAR; PG8_SCHED;
            PG8_LDA(At, 0, 1); PG8_STAGE(PG8_SB(0, 0), b2, voffB); PG8_STAGE(PG8_SB(0, 1), b2 + hstep, voffB); PG8_STAGE(PG8_SA(0, 0), a2, voffA);
            PG8_WAIT_V(8); PG8_WAIT_L(0); PG8_BAR; PG8_MMA(1, 0, At, B0); PG8_MMA(1, 1, At, B1); PG8_BAR; PG8_SCHED;
            PG8_LDB(B0, 1, 0); PG8_LDB(B1, 1, 1); PG8_SCHED; PG8_LDA(At, 1, 0); PG8_STAGE(PG8_SA(0, 1), a2 + hstep, voffA);
            PG8_WAIT_V(8); PG8_WAIT_L(0); PG8_BAR; PG8_MMA(0, 0, At, B0); PG8_MMA(0, 1, At, B1); PG8_BAR; PG8_SCHED;
            PG8_LDA(At, 1, 1); PG8_STAGE(PG8_SB(1, 0), b3, voffB); PG8_STAGE(PG8_SB(1, 1), b3 + hstep, voffB); PG8_STAGE(PG8_SA(1, 0), a3, voffA);
            PG8_WAIT_V(8); PG8_WAIT_L(0); PG8_BAR; PG8_MMA(1, 0, At, B0); PG8_MMA(1, 1, At, B1); PG8_BAR; PG8_SCHED;
            } else {
            PG8_LDB(B0, 0, 0); PG8_SCHED; PG8_LDA(At, 0, 0); PG8_STAGE(PG8_SA(1, 1), a1 + hstep, voffA);
            PG8_WAIT_L(8); PG8_BAR; PG8_WAIT_L(0); PG8_MMA(0, 0, At, B0); PG8_BAR; PG8_SCHED;
            PG8_LDB(B1, 0, 1); PG8_STAGE(PG8_SB(0, 0), b2, voffB);
            PG8_BAR; PG8_WAIT_L(0); PG8_MMA(0, 1, At, B1); PG8_BAR;
            PG8_LDA(At, 0, 1); PG8_STAGE(PG8_SA(0, 0), a2, voffA);
            PG8_BAR; PG8_WAIT_L(0); PG8_MMA(1, 0, At, B0); PG8_BAR; PG8_SCHED;
            PG8_STAGE(PG8_SB(0, 1), b2 + hstep, voffB);
            PG8_WAIT_V(6); PG8_BAR; PG8_MMA(1, 1, At, B1); PG8_BAR;
            PG8_LDB(B0, 1, 0); PG8_SCHED; PG8_LDA(At, 1, 0); PG8_STAGE(PG8_SA(0, 1), a2 + hstep, voffA);
            PG8_WAIT_L(8); PG8_BAR; PG8_WAIT_L(0); PG8_MMA(0, 0, At, B0); PG8_BAR; PG8_SCHED;
            PG8_LDB(B1, 1, 1); PG8_STAGE(PG8_SB(1, 0), b3, voffB);
            PG8_BAR; PG8_WAIT_L(0); PG8_MMA(0, 1, At, B1); PG8_BAR;
            PG8_LDA(At, 1, 1); PG8_STAGE(PG8_SA(1, 0), a3, voffA);
            PG8_BAR; PG8_WAIT_L(0); PG8_MMA(1, 0, At, B0); PG8_BAR; PG8_SCHED;
            PG8_STAGE(PG8_SB(1, 1), b3 + hstep, voffB);
            PG8_WAIT_V(6); PG8_BAR; PG8_MMA(1, 1, At, B1); PG8_BAR;
            }
        }
        if constexpr (ALIGN_EPI) { if (wr == 0) PG8_BAR; }
        if constexpr (!Epi::AFTER_DRAIN) { E(acc, cur, wr, wc, fr, fq); S.done(cur); }
        if (!has_next) break;
#pragma unroll
        for (int a = 0; a < 2; ++a)
#pragma unroll
            for (int b = 0; b < 2; ++b)
#pragma unroll
                for (int m = 0; m < 4; ++m)
#pragma unroll
                    for (int n = 0; n < 2; ++n) acc[a][b][m][n] = (f32x4){0.f, 0.f, 0.f, 0.f};
        cur = nxt; cA = nA; cB = nB; ++ui;
        if constexpr (ALIGN_EPI) { if (wr == 1) PG8_BAR; }
    }
    PG8_WAIT_V(0);
    if constexpr (!ALIGN_EPI) { if (wr == 0) PG8_BAR; }
    PG8_BAR;
    if constexpr (Epi::AFTER_DRAIN) { E.fused(acc, cur, wr, wc, fr, fq, lds, wid, lane); S.done(cur); }
#undef PG8_SA
#undef PG8_SB
#undef PG8_STAGE
#undef PG8_LDA
#undef PG8_LDB
#undef PG8_MMA
#undef PG8_WAIT_V
#undef PG8_WAIT_L
#undef PG8_BAR
#undef PG8_SCHED
}
}

#define LAS __attribute__((address_space(3)))
typedef unsigned short bf16;
typedef unsigned u32x4 __attribute__((ext_vector_type(4)));
typedef unsigned u32x2 __attribute__((ext_vector_type(2)));
typedef float f32x4 __attribute__((ext_vector_type(4)));
typedef short bf16x8 __attribute__((ext_vector_type(8)));

constexpr int DM = 1024, SEQ = 2048, NB = 8, M = NB * SEQ, DFF = 2816, NL = 2, MIXIN = 14336;
constexpr float EPS = 1e-6f;
constexpr int NWAVES = 8, NTHREADS = 512;
constexpr int LDS_BYTES = 147456;

constexpr size_t KiB = 1024, MiB = 1024 * 1024;
constexpr size_t WS_LRUW = 256 * KiB;
constexpr size_t WS_AGG  = 512 * KiB;
constexpr size_t WS_SS   = WS_AGG + 2 * MiB;
constexpr size_t WS_ROPE = WS_SS + 4 * MiB;
constexpr size_t WS_WF   = WS_ROPE + 2 * MiB;
constexpr size_t WS_WM   = WS_WF + 16 * MiB + 512 * KiB;
constexpr size_t WS_XN   = WS_WM + 38 * MiB;
constexpr size_t WS_MB   = WS_XN + 32 * MiB;
constexpr size_t WS_END  = WS_MB + 352 * MiB;
constexpr size_t MB_YA = 0, MB_SB = 32 * MiB, MB_XA = 64 * MiB, MB_SCSH = 96 * MiB, MB_Q = 128 * MiB, MB_K = 160 * MiB, MB_KT = 192 * MiB,
                 MB_VT = 224 * MiB, MB_G = 288 * MiB, MB_GATES = 128 * MiB, MB_MIX = 224 * MiB, MB_MIXB = 64 * MiB, MB_H = 96 * MiB, MB_ACT = 128 * MiB;

__device__ __forceinline__ unsigned f2bf(float f) { unsigned u = __builtin_bit_cast(unsigned, f); return (u + 0x7fffu + ((u >> 16) & 1u)) >> 16; }
__device__ __forceinline__ unsigned pk2(float lo, float hi) { return f2bf(lo) | (f2bf(hi) << 16); }
__device__ __forceinline__ float bflo(unsigned u) { return __builtin_bit_cast(float, u << 16); }
__device__ __forceinline__ float bfhi(unsigned u) { return __builtin_bit_cast(float, u & 0xffff0000u); }
__device__ __forceinline__ float sigm(float x) { return __builtin_amdgcn_rcpf(1.f + __builtin_amdgcn_exp2f(-1.4426950408889634f * x)); }
__device__ __forceinline__ float silu_f(float x) { return x * sigm(x); }
__device__ __forceinline__ float gelu_t(float x) { return x * sigm(1.5957691216057308f * (x + 0.044715f * x * x * x)); }
__device__ __forceinline__ void st8(bf16* p, f32x4 a, f32x4 b) {
    u32x4 w;
    asm volatile("s_nop 1\n\tv_cvt_pk_bf16_f32 %0, %4, %5\n\tv_cvt_pk_bf16_f32 %1, %6, %7\n\tv_cvt_pk_bf16_f32 %2, %8, %9\n\tv_cvt_pk_bf16_f32 %3, %10, %11"
                 : "=&v"(w.x), "=&v"(w.y), "=&v"(w.z), "=&v"(w.w)
                 : "v"(a[0]), "v"(a[1]), "v"(a[2]), "v"(a[3]), "v"(b[0]), "v"(b[1]), "v"(b[2]), "v"(b[3]));
    *(u32x4*)p = w;
}
__device__ __forceinline__ float wave_sum(float v) {
#pragma unroll
    for (int o = 1; o < 64; o <<= 1) v += __shfl_xor(v, o);
    return v;
}
#define LDS_WAIT() asm volatile("s_waitcnt lgkmcnt(0)" ::: "memory")
__device__ __forceinline__ const float* rd_ptr(LAS const unsigned long long* t, int i) {
    const unsigned long long v = t[i]; const unsigned lo = __builtin_amdgcn_readfirstlane((unsigned)v), hi = __builtin_amdgcn_readfirstlane((unsigned)(v >> 32));
    typedef __attribute__((address_space(1))) const float* gptr_t;
    return (const float*)(gptr_t)(((unsigned long long)hi << 32) | lo);
}

using pg8::Unit;
#define EPI_IDX int t__ = threadIdx.x; asm volatile("" : "+v"(t__)); const int wr = t__ >> 8, wc = (t__ >> 6) & 3, fr = t__ & 15, fq = (t__ >> 4) & 3; (void)wr_; (void)wc_; (void)fr_; (void)fq_
typedef const f32x4 (&AccRef)[2][2][4][2];

struct EpiSwiGLU {
    static constexpr bool PERM = true, AFTER_DRAIN = false; bf16* O;
    __device__ __forceinline__ void operator()(AccRef acc, const Unit& u, int wr_, int wc_, int fr_, int fq_) const {
        EPI_IDX;
        const int row0 = u.pm * 256 + wr * 64 + fr, col0 = u.pn * 128 + wc * 32 + 8 * fq;
#pragma unroll
        for (int ai = 0; ai < 2; ++ai)
#pragma unroll
            for (int m = 0; m < 4; ++m) {
                f32x4 o0, o1;
#pragma unroll
                for (int i = 0; i < 4; ++i) { o0[i] = silu_f(acc[ai][0][m][0][i]) * acc[ai][1][m][0][i]; o1[i] = silu_f(acc[ai][0][m][1][i]) * acc[ai][1][m][1][i]; }
                st8(O + (size_t)(row0 + ai * 128 + m * 16) * DFF + col0, o0, o1);
            }
    }
};
struct EpiStore {
    static constexpr bool PERM = true, AFTER_DRAIN = false; bf16* O; int ldc;
    __device__ __forceinline__ void operator()(AccRef acc, const Unit& u, int wr_, int wc_, int fr_, int fq_) const {
        EPI_IDX;
        const int row0 = u.pm * 256 + wr * 64 + fr, col0 = u.pn * 256 + wc * 32 + 8 * fq;
#pragma unroll
        for (int ai = 0; ai < 2; ++ai)
#pragma unroll
            for (int m = 0; m < 4; ++m)
#pragma unroll
                for (int bj = 0; bj < 2; ++bj) st8(O + (size_t)(row0 + ai * 128 + m * 16) * ldc + col0 + bj * 128, acc[ai][bj][m][0], acc[ai][bj][m][1]);
    }
};
struct EpiSet1 {
    static constexpr bool PERM = true, AFTER_DRAIN = false; unsigned char* mb;
    __device__ __forceinline__ void operator()(AccRef acc, const Unit& u, int wr_, int wc_, int fr_, int fq_) const {
        EPI_IDX;
        const int row0 = u.pm * 256 + wr * 64 + fr;
        if (u.pn < 12) {
            const int t = u.pn >> 2; bf16* base = (bf16*)(mb + (size_t)((t + 2) % 3) * (32 * MiB)); const int col0 = (u.pn & 3) * 256 + wc * 32 + 8 * fq;
#pragma unroll
            for (int ai = 0; ai < 2; ++ai)
#pragma unroll
                for (int m = 0; m < 4; ++m)
#pragma unroll
                    for (int bj = 0; bj < 2; ++bj) {
                        f32x4 v0 = acc[ai][bj][m][0], v1 = acc[ai][bj][m][1];
                        if (t == 1) {
#pragma unroll
                            for (int i = 0; i < 4; ++i) { v0[i] = gelu_t(v0[i]); v1[i] = gelu_t(v1[i]); }
                        }
                        st8(base + (size_t)(row0 + ai * 128 + m * 16) * DM + col0 + bj * 128, v0, v1);
                    }
        } else {
            const int col0 = (u.pn - 12) * 128 + wc * 32 + 8 * fq;
#pragma unroll
            for (int ai = 0; ai < 2; ++ai)
#pragma unroll
                for (int m = 0; m < 4; ++m) st8((bf16*)(mb + MB_SCSH) + (size_t)(row0 + ai * 128 + m * 16) * DM + col0, acc[ai][0][m][0] * acc[ai][1][m][0], acc[ai][0][m][1] * acc[ai][1][m][1]);
        }
    }
};
struct EpiSet2n {
    static constexpr bool PERM = true, AFTER_DRAIN = false; unsigned char* mb; const float *COS, *SIN;
    __device__ __forceinline__ void operator()(AccRef acc, const Unit& u, int wr_, int wc_, int fr_, int fq_) const {
        EPI_IDX;
        const int row0 = u.pm * 256 + wr * 64 + fr;
        if (u.pn >= 4 && u.pn < 12) {
            const int col0 = (u.pn - 4) * 256 + wc * 32 + 8 * fq;
#pragma unroll
            for (int ai = 0; ai < 2; ++ai)
#pragma unroll
                for (int m = 0; m < 4; ++m)
#pragma unroll
                    for (int bj = 0; bj < 2; ++bj) {
                        f32x4 v0 = acc[ai][bj][m][0], v1 = acc[ai][bj][m][1];
#pragma unroll
                        for (int i = 0; i < 4; ++i) { v0[i] = silu_f(v0[i]); v1[i] = silu_f(v1[i]); }
                        st8((bf16*)(mb + MB_G) + (size_t)(row0 + ai * 128 + m * 16) * 2048 + col0 + bj * 128, v0, v1);
                    }
        } else {
            const bool isk = u.pn >= 12; const int h = u.pn & 3; bf16* base = (bf16*)(mb + MB_Q + (isk ? 32 * MiB : 0)); const float sc = isk ? 0.0625f : 1.0f;
            const int j0 = wc * 32 + 8 * fq;
#pragma unroll
            for (int ai = 0; ai < 2; ++ai)
#pragma unroll
                for (int m = 0; m < 4; ++m) {
                    const int row = row0 + ai * 128 + m * 16, t = row & (SEQ - 1);
                    const f32x4 c0 = *(const f32x4*)(COS + t * 128 + j0), c1 = *(const f32x4*)(COS + t * 128 + j0 + 4);
                    const f32x4 s0 = *(const f32x4*)(SIN + t * 128 + j0), s1 = *(const f32x4*)(SIN + t * 128 + j0 + 4);
                    const f32x4 a0 = acc[ai][0][m][0], a1 = acc[ai][0][m][1], b0 = acc[ai][1][m][0], b1 = acc[ai][1][m][1];
                    bf16* p = base + (size_t)row * DM + h * 256 + j0;
                    st8(p, (a0 * c0 - b0 * s0) * sc, (a1 * c1 - b1 * s1) * sc);
                    st8(p + 128, (a0 * s0 + b0 * c0) * sc, (a1 * s1 + b1 * c1) * sc);
                    asm volatile("" ::: "memory");
                }
        }
    }
};
struct EpiSet2t {
    static constexpr bool PERM = true, AFTER_DRAIN = false; bf16 *KT, *VT; const float *COS, *SIN;
    __device__ __forceinline__ void operator()(AccRef acc, const Unit& u, int wr_, int wc_, int fr_, int fq_) const {
        EPI_IDX;
        const int tok0 = u.pn * 256 + wc * 32 + 8 * fq;
        if (u.pm >= 4) {
            const int ch0 = (u.pm - 4) * 256 + wr * 64 + fr;
#pragma unroll
            for (int ai = 0; ai < 2; ++ai)
#pragma unroll
                for (int m = 0; m < 4; ++m)
#pragma unroll
                    for (int bj = 0; bj < 2; ++bj) st8(VT + (size_t)(ch0 + ai * 128 + m * 16) * M + tok0 + bj * 128, acc[ai][bj][m][0], acc[ai][bj][m][1]);
        } else {
#pragma unroll
            for (int m = 0; m < 4; ++m) {
                const int j = wr * 64 + m * 16 + fr;
#pragma unroll
                for (int bj = 0; bj < 2; ++bj) {
                    f32x4 o1[2], o2[2];
#pragma unroll
                    for (int n = 0; n < 2; ++n)
#pragma unroll
                        for (int i = 0; i < 4; ++i) {
                            const int t = (tok0 + bj * 128 + 4 * n + i) & (SEQ - 1);
                            const float c = COS[t * 128 + j], s = SIN[t * 128 + j];
                            const float a = acc[0][bj][m][n][i], b = acc[1][bj][m][n][i];
                            o1[n][i] = (a * c - b * s) * 0.0625f; o2[n][i] = (a * s + b * c) * 0.0625f;
                        }
                    st8(KT + (size_t)(u.pm * 256 + j) * M + tok0 + bj * 128, o1[0], o1[1]);
                    st8(KT + (size_t)(u.pm * 256 + 128 + j) * M + tok0 + bj * 128, o2[0], o2[1]);
                    asm volatile("" ::: "memory");
                }
            }
        }
    }
};
struct EpiGates {
    static constexpr bool PERM = true, AFTER_DRAIN = false; bf16* O;
    __device__ __forceinline__ void operator()(AccRef acc, const Unit& u, int wr_, int wc_, int fr_, int fq_) const {
        EPI_IDX;
        const int row0 = u.pm * 256 + wr * 64 + fr, col0 = u.pn * 256 + wc * 32 + 8 * fq;
#pragma unroll
        for (int ai = 0; ai < 2; ++ai)
#pragma unroll
            for (int m = 0; m < 4; ++m)
#pragma unroll
                for (int bj = 0; bj < 2; ++bj) {
                    f32x4 v0 = acc[ai][bj][m][0], v1 = acc[ai][bj][m][1];
#pragma unroll
                    for (int i = 0; i < 4; ++i) { v0[i] = sigm(v0[i]); v1[i] = sigm(v1[i]); }
                    st8(O + (size_t)(row0 + ai * 128 + m * 16) * 3072 + col0 + bj * 128, v0, v1);
                }
    }
};
struct EpiMix {
    static constexpr bool PERM = true, AFTER_DRAIN = false; const bf16* GATES; float* MIX; bf16* MIXB; int goff, mode;
    __device__ __forceinline__ void operator()(AccRef acc, const Unit& u, int wr_, int wc_, int fr_, int fq_) const {
        EPI_IDX;
        const int row0 = u.pm * 256 + wr * 64 + fr, col0 = u.pn * 256 + wc * 32 + 8 * fq;
#pragma unroll
        for (int ai = 0; ai < 2; ++ai)
#pragma unroll
            for (int m = 0; m < 4; ++m)
#pragma unroll
                for (int bj = 0; bj < 2; ++bj) {
                    const size_t row = (size_t)(row0 + ai * 128 + m * 16); const int col = col0 + bj * 128;
                    const u32x4 gw = *(const u32x4*)(GATES + row * 3072 + goff + col);
                    f32x4 g0 = {bflo(gw.x), bfhi(gw.x), bflo(gw.y), bfhi(gw.y)}, g1 = {bflo(gw.z), bfhi(gw.z), bflo(gw.w), bfhi(gw.w)};
                    f32x4 v0 = acc[ai][bj][m][0] * g0, v1 = acc[ai][bj][m][1] * g1;
                    float* mp = MIX + row * DM + col;
                    if (mode == 1 || mode == 2 || mode == 4) { v0 += *(const f32x4*)mp; v1 += *(const f32x4*)(mp + 4); }
                    if (mode < 2) { *(f32x4*)mp = v0; *(f32x4*)(mp + 4) = v1; }
                    else st8(MIXB + row * DM + col, v0, v1);
                    asm volatile("" ::: "memory");
                }
    }
};

__device__ __forceinline__ void tr_item(const float* W, int K, int N, bf16* WT, int k0, int n0, int drow0, LAS float* scr, int lane) {
#pragma unroll 8
    for (int i = 0; i < 32; ++i) { const int kk = 2 * i + (lane >> 5); scr[kk * 33 + (lane & 31)] = W[(size_t)(k0 + kk) * N + n0 + (lane & 31)]; }
    LDS_WAIT(); asm volatile("" ::: "memory");
    const int c = lane & 7;
#pragma unroll
    for (int j = 0; j < 4; ++j) { const int n = (lane >> 3) + 8 * j; const LAS float* s = scr + (8 * c) * 33 + n;
        u32x4 o; o.x = pk2(s[0 * 33], s[1 * 33]); o.y = pk2(s[2 * 33], s[3 * 33]); o.z = pk2(s[4 * 33], s[5 * 33]); o.w = pk2(s[6 * 33], s[7 * 33]);
        *(u32x4*)(WT + (size_t)(drow0 + n) * K + k0 + 8 * c) = o; }
    LDS_WAIT(); asm volatile("" ::: "memory");
}
__device__ __forceinline__ int maprow(int kind, int n0) {
    if (kind == 0) return n0;
    if (kind == 1) { const int j = n0 < DFF ? n0 : n0 - DFF; return 256 * (j >> 7) + (j & 127) + (n0 < DFF ? 0 : 128); }
    if (n0 < 2048) return n0;
    if (n0 < 3072) return 5120 + (n0 - 2048);
    if (n0 < 4096) return 8192 + (n0 - 3072);
    if (n0 < 6144) return 9216 + (n0 - 4096);
    if (n0 < 8192) return n0;
    if (n0 < 9216) return 2048 + (n0 - 8192);
    if (n0 < 10240) { const int j = n0 - 9216; return 3072 + 256 * (j >> 7) + (j & 127); }
    if (n0 < 11264) { const int j = n0 - 10240; return 3072 + 256 * (j >> 7) + 128 + (j & 127); }
    return n0;
}
__device__ __forceinline__ void prep_matrix(const float* W, int K, int N, bf16* WT, int kind, LAS float* scr, int gw, int NGW, int lane) {
    const int nblk = N / 32, nitems = (K / 64) * nblk;
    for (int it = gw; it < nitems; it += NGW) { const int kb = it / nblk, nb = it % nblk; tr_item(W, K, N, WT, 64 * kb, 32 * nb, maprow(kind, 32 * nb), scr, lane); }
}

__device__ __forceinline__ void norm_phase(const float* Xin, const bf16* H, float coef, const float* post_g, const float* pre_g, float* Xout, bf16* XN, int gw, int NGW, int lane) {
    for (int row = gw; row < M; row += NGW) {
        f32x4 v[4];
#pragma unroll
        for (int j = 0; j < 4; ++j) v[j] = *((const f32x4*)(Xin + (size_t)row * DM) + lane + 64 * j);
        if (H) {
            f32x4 h[4]; float ss = 0.f;
#pragma unroll
            for (int j = 0; j < 4; ++j) { const u32x2 w = *((const u32x2*)(H + (size_t)row * DM) + lane + 64 * j); h[j] = (f32x4){bflo(w.x), bfhi(w.x), bflo(w.y), bfhi(w.y)};
                ss += (h[j][0] * h[j][0] + h[j][1] * h[j][1]) + (h[j][2] * h[j][2] + h[j][3] * h[j][3]); }
            const float rs = coef * __builtin_amdgcn_rsqf(wave_sum(ss) * (1.f / DM) + EPS);
#pragma unroll
            for (int j = 0; j < 4; ++j) { const f32x4 g = *((const f32x4*)post_g + lane + 64 * j); v[j] += h[j] * rs * g; }
        }
#pragma unroll
        for (int j = 0; j < 4; ++j) *((f32x4*)(Xout + (size_t)row * DM) + lane + 64 * j) = v[j];
        if (pre_g) {
            float ss = 0.f;
#pragma unroll
            for (int j = 0; j < 4; ++j) ss += (v[j][0] * v[j][0] + v[j][1] * v[j][1]) + (v[j][2] * v[j][2] + v[j][3] * v[j][3]);
            const float rs = __builtin_amdgcn_rsqf(wave_sum(ss) * (1.f / DM) + EPS);
#pragma unroll
            for (int j = 0; j < 4; ++j) { const f32x4 g = *((const f32x4*)pre_g + lane + 64 * j); const f32x4 o = v[j] * rs * g;
                u32x2 w; w.x = pk2(o[0], o[1]); w.y = pk2(o[2], o[3]); *((u32x2*)(XN + (size_t)row * DM) + lane + 64 * j) = w; }
        }
    }
}

__device__ __forceinline__ void rope_tables(const int* pos, float* COS, float* SIN, int gtid, int GT) {
    for (int idx = gtid; idx < SEQ * 128; idx += GT) {
        const int t = idx >> 7, j = idx & 127;
        double f = 1.0, r = 0.9305720409296989;
#pragma unroll
        for (int b = 0; b < 7; ++b) { if ((j >> b) & 1) f *= r; r *= r; }
        const double rev = (double)pos[t] * f * 0.15915494309189535;
        const float fr = (float)(rev - __builtin_floor(rev));
        COS[idx] = __builtin_amdgcn_cosf(fr); SIN[idx] = __builtin_amdgcn_sinf(fr);
    }
}

__device__ __forceinline__ void ac_phase(bf16* SB, const bf16* SCSH, const float* cw  , int gtid, int GT) {
    for (int idx = gtid; idx < M * 128; idx += GT) {
        const int row = idx >> 7, c0 = (idx & 127) * 8, t = row & (SEQ - 1);
        float accv[8];
#pragma unroll
        for (int e = 0; e < 8; ++e) accv[e] = 0.f;
#pragma unroll
        for (int k = 0; k < 3; ++k) {
            if (t - 2 + k >= 0) {
                const u32x4 w = *(const u32x4*)(SCSH + (size_t)(row - 2 + k) * DM + c0);
                const f32x4 w0 = *(const f32x4*)(cw + k * DM + c0), w1 = *(const f32x4*)(cw + k * DM + c0 + 4);
                accv[0] += w0[0] * bflo(w.x); accv[1] += w0[1] * bfhi(w.x); accv[2] += w0[2] * bflo(w.y); accv[3] += w0[3] * bfhi(w.y);
                accv[4] += w1[0] * bflo(w.z); accv[5] += w1[1] * bfhi(w.z); accv[6] += w1[2] * bflo(w.w); accv[7] += w1[3] * bfhi(w.w);
            }
        }
        const u32x4 s = *(const u32x4*)(SB + (size_t)row * DM + c0);
        u32x4 o; o.x = pk2(accv[0] * bflo(s.x), accv[1] * bfhi(s.x)); o.y = pk2(accv[2] * bflo(s.y), accv[3] * bfhi(s.y));
        o.z = pk2(accv[4] * bflo(s.z), accv[5] * bfhi(s.z)); o.w = pk2(accv[6] * bflo(s.w), accv[7] * bfhi(s.w));
        *(u32x4*)(SB + (size_t)row * DM + c0) = o;
    }
}

__device__ __forceinline__ void retnorm_phase(bf16* RET, const float* SS, int gw, int NGW, int lane) {
    for (int row = gw; row < M; row += NGW) {
        float s = SS[(size_t)row * 64 + lane];
        s += __shfl_xor(s, 1); s += __shfl_xor(s, 2); s += __shfl_xor(s, 4); s += __shfl_xor(s, 8);
        const float rs = __builtin_amdgcn_rsqf(s * (1.f / 512.f) + EPS);
        bf16* p = RET + (size_t)row * 2048 + lane * 32;
#pragma unroll
        for (int j = 0; j < 4; ++j) { u32x4 w = *((u32x4*)p + j);
            w.x = pk2(bflo(w.x) * rs, bfhi(w.x) * rs); w.y = pk2(bflo(w.y) * rs, bfhi(w.y) * rs); w.z = pk2(bflo(w.z) * rs, bfhi(w.z) * rs); w.w = pk2(bflo(w.w) * rs, bfhi(w.w) * rs);
            *((u32x4*)p + j) = w; }
    }
}

#define MFMA16(a, b, c) __builtin_amdgcn_mfma_f32_16x16x32_bf16((a), (b), (c), 0, 0, 0)
template <bool FINAL>
__device__ __forceinline__ void lru_phase(const bf16* XA, bf16* YA, const float* convw, const float* convb, const bf16* WaT, const bf16* WxT,
                                          const float* ba, const float* bx, const float* lam, float* AGGA, float* AGGH, int gw, int NGW, int lane) {
    const int r = lane & 15, q = lane >> 4;
    for (int item = gw; item < NB * 32 * 16; item += NGW) {
        const int g = item & 15, s = (item >> 4) & 31, b = item >> 9;
        const size_t rowb = (size_t)b * SEQ;
        bf16x8 xf[4][2];
#pragma unroll
        for (int ks = 0; ks < 2; ++ks) {
            const int c0 = 64 * g + 32 * ks + 8 * q;
            f32x4 w0[4], w1[4];
#pragma unroll
            for (int k = 0; k < 4; ++k) { w0[k] = *(const f32x4*)(convw + k * DM + c0); w1[k] = *(const f32x4*)(convw + k * DM + c0 + 4); }
            const f32x4 b0 = *(const f32x4*)(convb + c0), b1 = *(const f32x4*)(convb + c0 + 4);
#pragma unroll
            for (int tt = 0; tt < 4; ++tt) {
                const int t = 64 * s + 16 * tt + r;
                f32x4 x0 = b0, x1 = b1;
#pragma unroll
                for (int k = 0; k < 4; ++k) {
                    const int tk = t - 3 + k;
                    if (tk >= 0) { const u32x4 w = *(const u32x4*)(XA + (rowb + tk) * DM + c0);
                        x0 += w0[k] * (f32x4){bflo(w.x), bfhi(w.x), bflo(w.y), bfhi(w.y)}; x1 += w1[k] * (f32x4){bflo(w.z), bfhi(w.z), bflo(w.w), bfhi(w.w)}; }
                }
                u32x4 p; p.x = pk2(x0[0], x0[1]); p.y = pk2(x0[2], x0[3]); p.z = pk2(x1[0], x1[1]); p.w = pk2(x1[2], x1[3]);
                xf[tt][ks] = __builtin_bit_cast(bf16x8, p);
                asm volatile("" ::: "memory");
            }
        }
#pragma unroll 1
        for (int ct = 0; ct < 4; ++ct) {
            bf16x8 af[2], xw[2];
#pragma unroll
            for (int ks = 0; ks < 2; ++ks) { af[ks] = *(const bf16x8*)(WaT + g * 4096 + (16 * ct + r) * 64 + 32 * ks + 8 * q); xw[ks] = *(const bf16x8*)(WxT + g * 4096 + (16 * ct + r) * 64 + 32 * ks + 8 * q); }
            f32x4 aR[4], aI[4];
#pragma unroll
            for (int tt = 0; tt < 4; ++tt) { aR[tt] = (f32x4){0.f, 0.f, 0.f, 0.f}; aI[tt] = (f32x4){0.f, 0.f, 0.f, 0.f};
#pragma unroll
                for (int ks = 0; ks < 2; ++ks) { aR[tt] = MFMA16(af[ks], xf[tt][ks], aR[tt]); aI[tt] = MFMA16(xw[ks], xf[tt][ks], aI[tt]); } }
            const int ch0 = 64 * g + 16 * ct + 4 * q;
            const f32x4 ba4 = *(const f32x4*)(ba + ch0), bx4 = *(const f32x4*)(bx + ch0), lam4 = *(const f32x4*)(lam + ch0), cb = *(const f32x4*)(convb + ch0);
            f32x4 cw[4], sp4;
#pragma unroll
            for (int k = 0; k < 4; ++k) cw[k] = *(const f32x4*)(convw + k * DM + ch0);
#pragma unroll
            for (int jj = 0; jj < 4; ++jj) { const float z = -lam4[jj]; sp4[jj] = (z > 0.f ? z : 0.f) + log1pf(__expf(-fabsf(z))); }
            f32x4 Ain = {1.f, 1.f, 1.f, 1.f}, Hin = {0.f, 0.f, 0.f, 0.f};
            if (FINAL) {
                for (int sp = 0; sp < s; ++sp) { const f32x4 a4 = *(const f32x4*)(AGGA + (size_t)(b * 32 + sp) * DM + ch0), h4 = *(const f32x4*)(AGGH + (size_t)(b * 32 + sp) * DM + ch0); Hin = a4 * Hin + h4; }
            }
#pragma unroll
            for (int tt = 0; tt < 4; ++tt) {
                const int t = 64 * s + 16 * tt + r;
                f32x4 xp = cb;
#pragma unroll
                for (int k = 0; k < 4; ++k) { const int tk = t - 3 + k;
                    if (tk >= 0) { const u32x2 w = *(const u32x2*)(XA + (rowb + tk) * DM + ch0); xp += cw[k] * (f32x4){bflo(w.x), bfhi(w.x), bflo(w.y), bfhi(w.y)}; } }
                f32x4 av, uv;
#pragma unroll
                for (int jj = 0; jj < 4; ++jj) {
                    const float rr = sigm(aR[tt][jj] + ba4[jj]), ii = sigm(aI[tt][jj] + bx4[jj]);
                    const float la = -8.0f * rr * sp4[jj];
                    av[jj] = __expf(la); uv[jj] = __builtin_sqrtf(-expm1f(2.0f * la)) * ii * xp[jj];
                }
#pragma unroll
                for (int d = 1; d < 16; d <<= 1) {
#pragma unroll
                    for (int jj = 0; jj < 4; ++jj) {
                        const float ap = __shfl_up(av[jj], d, 16), up = __shfl_up(uv[jj], d, 16);
                        if (r >= d) { uv[jj] = av[jj] * up + uv[jj]; av[jj] = av[jj] * ap; }
                    }
                }
                f32x4 hv = uv + av * Hin;
                if (FINAL) {
                    bf16* yp = YA + (rowb + t) * DM + ch0; const u32x2 w = *(const u32x2*)yp;
                    u32x2 o; o.x = pk2(hv[0] * bflo(w.x), hv[1] * bfhi(w.x)); o.y = pk2(hv[2] * bflo(w.y), hv[3] * bfhi(w.y)); *(u32x2*)yp = o;
                }
#pragma unroll
                for (int jj = 0; jj < 4; ++jj) { Hin[jj] = __shfl(hv[jj], 15, 16); if (!FINAL) Ain[jj] *= __shfl(av[jj], 15, 16); }
                asm volatile("" ::: "memory");
            }
            if (!FINAL && r == 0) { *(f32x4*)(AGGA + (size_t)(b * 32 + s) * DM + ch0) = Ain; *(f32x4*)(AGGH + (size_t)(b * 32 + s) * DM + ch0) = Hin; }
        }
    }
}

constexpr int R_KS = 0, R_ST = 33792, R_VT = 67584, R_VP = 76800, R_P = 95232;
__device__ __forceinline__ void retention_phase(LAS unsigned char* lds, const bf16* Q, const bf16* K, const bf16* KT, const bf16* VT, bf16* G, float* SS, int bid, int nblk, int tid) {
    const int w = __builtin_amdgcn_readfirstlane(tid >> 6), lane = tid & 63, r = lane & 15, q = lane >> 4, it = w & 3, hh = w >> 2;
    for (int item = bid; item < 256; item += nblk) {
        const int xcd = item & 7, loc = item >> 3, pair = xcd * 4 + (loc >> 3), slice = loc & 7, b = pair >> 2, h = pair & 3;
        const float log2g = __builtin_amdgcn_logf(1.0f - __builtin_amdgcn_exp2f(-5.0f - (float)h));
        const float cd = __builtin_amdgcn_exp2f(log2g * 64.0f);
        for (int i = tid; i < 33792 / 16; i += NTHREADS) *(LAS u32x4*)(lds + R_ST + i * 16) = (u32x4){0u, 0u, 0u, 0u};
        f32x4 st[2][4];
#pragma unroll
        for (int a = 0; a < 2; ++a)
#pragma unroll
            for (int e = 0; e < 4; ++e) st[a][e] = (f32x4){0.f, 0.f, 0.f, 0.f};
        __syncthreads();
#pragma unroll 1
        for (int n = 0; n < 32; ++n) {
            const size_t rowbase = (size_t)b * SEQ + n * 64;
            u32x4 kreg[4];
#pragma unroll
            for (int i = 0; i < 4; ++i) { const int p = tid + NTHREADS * i, row = p >> 5, c16 = p & 31; kreg[i] = *(const u32x4*)(K + (rowbase + row) * DM + h * 256 + c16 * 8); }
            const int ve = tid >> 3, vc = tid & 7;
            const u32x4 vreg = *(const u32x4*)(VT + (size_t)(h * 512 + slice * 64 + ve) * M + rowbase + vc * 8);
            bf16x8 qf[8], ktf[2][2];
#pragma unroll
            for (int ks = 0; ks < 8; ++ks) qf[ks] = *(const bf16x8*)(Q + (rowbase + 16 * it + r) * DM + h * 256 + 32 * ks + 8 * q);
#pragma unroll
            for (int dl = 0; dl < 2; ++dl)
#pragma unroll
                for (int ks = 0; ks < 2; ++ks) ktf[dl][ks] = *(const bf16x8*)(KT + (size_t)(h * 256 + 32 * w + 16 * dl + r) * M + rowbase + 32 * ks + 8 * q);
#pragma unroll
            for (int i = 0; i < 4; ++i) { const int p = tid + NTHREADS * i, row = p >> 5, c16 = p & 31; *(LAS u32x4*)(lds + R_KS + row * 528 + c16 * 16) = kreg[i]; }
            *(LAS u32x4*)(lds + R_VT + ve * 144 + vc * 16) = vreg;
            {
                float kd[8];
#pragma unroll
                for (int e = 0; e < 8; ++e) kd[e] = __builtin_amdgcn_exp2f(log2g * (float)(63 - (vc * 8 + e)));
                u32x4 o; o.x = pk2(bflo(vreg.x) * kd[0], bfhi(vreg.x) * kd[1]); o.y = pk2(bflo(vreg.y) * kd[2], bfhi(vreg.y) * kd[3]);
                o.z = pk2(bflo(vreg.z) * kd[4], bfhi(vreg.z) * kd[5]); o.w = pk2(bflo(vreg.w) * kd[6], bfhi(vreg.w) * kd[7]);
                *(LAS u32x4*)(lds + R_VP + (n & 1) * 9216 + ve * 144 + vc * 16) = o;
            }
            __syncthreads();
#pragma unroll
            for (int jl = 0; jl < 2; ++jl) {
                const int jt = 2 * hh + jl; f32x4 acc = {0.f, 0.f, 0.f, 0.f};
#pragma unroll
                for (int ks = 0; ks < 8; ++ks) { const bf16x8 kf = *(const LAS bf16x8*)(lds + R_KS + (16 * jt + r) * 528 + (32 * ks + 8 * q) * 2); acc = MFMA16(kf, qf[ks], acc); }
                const int i_ = 16 * it + r, j0 = 16 * jt + 4 * q;
                float p[4];
#pragma unroll
                for (int jj = 0; jj < 4; ++jj) { const int dd = i_ - (j0 + jj); p[jj] = acc[jj] * __builtin_amdgcn_exp2f(log2g * (float)(dd < 0 ? -dd : dd)); }
                u32x2 o; o.x = pk2(p[0], p[1]); o.y = pk2(p[2], p[3]);
                *(LAS u32x2*)(lds + R_P + i_ * 144 + j0 * 2) = o;
            }
            __syncthreads();
            {
                const float qd = __builtin_amdgcn_exp2f(log2g * (float)(16 * it + r + 1));
                float ss = 0.f;
#pragma unroll
                for (int el = 0; el < 2; ++el) {
                    const int et = 2 * hh + el; f32x4 acc = {0.f, 0.f, 0.f, 0.f};
#pragma unroll
                    for (int ks = 0; ks < 8; ++ks) { const bf16x8 sf = *(const LAS bf16x8*)(lds + R_ST + (16 * et + r) * 528 + (32 * ks + 8 * q) * 2); acc = MFMA16(sf, qf[ks], acc); }
                    acc = acc * qd;
#pragma unroll
                    for (int ks = 0; ks < 2; ++ks) { const bf16x8 vf = *(const LAS bf16x8*)(lds + R_VT + (16 * et + r) * 144 + (32 * ks + 8 * q) * 2);
                        const bf16x8 pf = *(const LAS bf16x8*)(lds + R_P + (16 * it + r) * 144 + (32 * ks + 8 * q) * 2); acc = MFMA16(vf, pf, acc); }
                    ss += (acc[0] * acc[0] + acc[1] * acc[1]) + (acc[2] * acc[2] + acc[3] * acc[3]);
                    bf16* gp = G + (rowbase + 16 * it + r) * 2048 + h * 512 + slice * 64 + 16 * et + 4 * q;
                    const u32x2 gv = *(const u32x2*)gp;
                    u32x2 o; o.x = pk2(acc[0] * bflo(gv.x), acc[1] * bfhi(gv.x)); o.y = pk2(acc[2] * bflo(gv.y), acc[3] * bfhi(gv.y));
                    *(u32x2*)gp = o;
                }
                ss += __shfl_xor(ss, 16); ss += __shfl_xor(ss, 32);
                if (q == 0) SS[((rowbase + 16 * it + r) * 4 + h) * 16 + slice * 2 + hh] = ss;
            }
            __syncthreads();
#pragma unroll
            for (int dl = 0; dl < 2; ++dl)
#pragma unroll
                for (int et = 0; et < 4; ++et) {
                    f32x4 a = st[dl][et] * cd;
#pragma unroll
                    for (int ks = 0; ks < 2; ++ks) { const bf16x8 vp = *(const LAS bf16x8*)(lds + R_VP + (n & 1) * 9216 + (16 * et + r) * 144 + (32 * ks + 8 * q) * 2); a = MFMA16(ktf[dl][ks], vp, a); }
                    st[dl][et] = a;
                    u32x2 o; o.x = pk2(a[0], a[1]); o.y = pk2(a[2], a[3]);
                    *(LAS u32x2*)(lds + R_ST + (16 * et + r) * 528 + (32 * w + 16 * dl + 4 * q) * 2) = o;
                }
        }
        __syncthreads();
    }
}


#define PH_IDX int tid = threadIdx.x; asm volatile("" : "+v"(tid)); const int lane = tid & 63, wave = __builtin_amdgcn_readfirstlane(tid >> 6), gw = bid * NWAVES + wave, gtid = bid * NTHREADS + tid; \
        LAS float* scr = (LAS float*)(lds + wave * 16384); (void)lane; (void)gw; (void)gtid; (void)scr
#define WSP(T, off) ((T*)(wsb + (off)))
#define MBP(T, off) ((T*)(wsb + WS_MB + (off)))
#define IN_L(idx, l, n) (rd_ptr(ptab, idx) + (size_t)(l) * (n))
#define PREP_FFN(widx_in, widx_out, l) do { prep_matrix(IN_L(widx_in, l, (size_t)DM * 2 * DFF), DM, 2 * DFF, WSP(bf16, WS_WF), 1, scr, gw, NGW, lane); \
        prep_matrix(IN_L(widx_out, l, (size_t)DFF * DM), DFF, DM, WSP(bf16, WS_WF) + (size_t)2 * DFF * DM, 0, scr, gw, NGW, lane); } while (0)
#define WM_IN_  WSP(bf16, WS_WM)
#define WM_LRU_ (WM_IN_ + (size_t)MIXIN * DM)
#define WM_SC_  (WM_LRU_ + (size_t)DM * DM)
#define WM_RET_ (WM_SC_ + (size_t)DM * DM)
#define WM_OUT_ (WM_RET_ + (size_t)2048 * DM)
#define WAT_ WSP(bf16, WS_LRUW)
#define WXT_ (WSP(bf16, WS_LRUW) + 16 * 64 * 64)
#define PREP_MIX(l) do { prep_matrix(IN_L(7, l, (size_t)DM * MIXIN), DM, MIXIN, WM_IN_, 2, scr, gw, NGW, lane); \
        prep_matrix(IN_L(15, l, (size_t)DM * DM), DM, DM, WM_LRU_, 0, scr, gw, NGW, lane); prep_matrix(IN_L(18, l, (size_t)DM * DM), DM, DM, WM_SC_, 0, scr, gw, NGW, lane); \
        prep_matrix(IN_L(16, l, (size_t)2048 * DM), 2048, DM, WM_RET_, 0, scr, gw, NGW, lane); prep_matrix(IN_L(19, l, (size_t)DM * DM), DM, DM, WM_OUT_, 0, scr, gw, NGW, lane); \
        for (int g_ = 0; g_ < 16; ++g_) { prep_matrix(IN_L(10, l, 65536) + g_ * 4096, 64, 64, WAT_ + g_ * 4096, 0, scr, gw, NGW, lane); prep_matrix(IN_L(12, l, 65536) + g_ * 4096, 64, 64, WXT_ + g_ * 4096, 0, scr, gw, NGW, lane); } } while (0)
#define COS_ WSP(float, WS_ROPE)
#define SIN_ (WSP(float, WS_ROPE) + SEQ * 128)
#define AGGA_ WSP(float, WS_AGG)
#define AGGH_ (WSP(float, WS_AGG) + NB * 32 * DM)


#if defined(CHECK)
__device__ __forceinline__ float bfa(const bf16* p, size_t i) { return __builtin_bit_cast(float, (unsigned)p[i] << 16); }
__device__ __forceinline__ float dotx(const bf16* XN, size_t row, const bf16* W, size_t wrow) { float a = 0.f; for (int k = 0; k < DM; ++k) a += bfa(XN, row * DM + k) * bfa(W, wrow * DM + k); return a; }
__device__ __forceinline__ bool badv(float got, float e, float rel, float ab) { return !(fabsf(got - e) <= rel * fabsf(e) + ab); }
__device__ __forceinline__ void flag(float* DB, int s, float w) { if (DB[s] < w) DB[s] = w; }
struct ChkP { LAS const unsigned long long* pt; unsigned char* wsb; float* DB; };
#define CK_ROW(s) (((s) * 37 + ((s) >> 14) * 4099 + ((s) >> 4) * 263) & (M - 1))
#define CK_H1(s) ((unsigned)(s) * 2654435761u >> 7)
__device__ __forceinline__ void chk_stage(const ChkP& P, int stage, int s) {
    unsigned char* wsb = P.wsb; float* DB = P.DB;
    const bf16* XN = WSP(bf16, WS_XN); const bf16* W = WM_IN_;
    const size_t row = CK_ROW(s); const unsigned hh = CK_H1(s); const int c = hh & 1023; const int t = (int)(row & (SEQ - 1)); const size_t rowb = row - t;
    if (stage == 0) {
        const int n = hh % MIXIN, k = (hh >> 5) & 1023;
        if (bfa(W, (size_t)(maprow(2, n & ~31) + (n & 31)) * DM + k) != __builtin_bit_cast(float, f2bf(rd_ptr(P.pt, 7)[(size_t)k * MIXIN + n]) << 16)) flag(DB, s, 1e13f);
        const int j2 = (hh >> 3) & 2047;
        if (bfa(WM_RET_, (size_t)c * 2048 + j2) != __builtin_bit_cast(float, f2bf(rd_ptr(P.pt, 16)[(size_t)j2 * DM + c]) << 16)) flag(DB, s, 1e13f);
        const int j1 = j2 & 1023;
        if (bfa(WM_LRU_, (size_t)c * DM + j1) != __builtin_bit_cast(float, f2bf(rd_ptr(P.pt, 15)[(size_t)j1 * DM + c]) << 16)) flag(DB, s, 1e13f);
        if (bfa(WM_SC_, (size_t)c * DM + j1) != __builtin_bit_cast(float, f2bf(rd_ptr(P.pt, 18)[(size_t)j1 * DM + c]) << 16)) flag(DB, s, 1e13f);
        if (bfa(WM_OUT_, (size_t)c * DM + j1) != __builtin_bit_cast(float, f2bf(rd_ptr(P.pt, 19)[(size_t)j1 * DM + c]) << 16)) flag(DB, s, 1e13f);
        const int g = c >> 6, jo = c & 63, ii = j1 & 63;
        if (bfa(WAT_, (size_t)g * 4096 + jo * 64 + ii) != __builtin_bit_cast(float, f2bf(rd_ptr(P.pt, 10)[(size_t)g * 4096 + ii * 64 + jo]) << 16)) flag(DB, s, 1e13f);
        if (bfa(WXT_, (size_t)g * 4096 + jo * 64 + ii) != __builtin_bit_cast(float, f2bf(rd_ptr(P.pt, 12)[(size_t)g * 4096 + ii * 64 + jo]) << 16)) flag(DB, s, 1e13f);
        const int j = c & 127; double f = 1.0, r = 0.9305720409296989; for (int b = 0; b < 7; ++b) { if ((j >> b) & 1) f *= r; r *= r; }
        double ang = (double)((const int*)rd_ptr(P.pt, 1))[t] * f; ang -= 6.283185307179586 * __builtin_floor(ang * 0.15915494309189535 + 0.5);
        double cs = 1.0, sn = ang, term = 1.0, a2 = ang * ang; term = 1.0; double tc = 1.0, ts = ang;
        for (int n2 = 1; n2 < 14; ++n2) { tc *= -a2 / ((2.0 * n2 - 1.0) * (2.0 * n2)); cs += tc; ts *= -a2 / ((2.0 * n2) * (2.0 * n2 + 1.0)); sn += ts; }
        (void)term;
        if (badv(COS_[t * 128 + j], (float)cs, 0.f, 2e-5f) || badv(SIN_[t * 128 + j], (float)sn, 0.f, 2e-5f)) flag(DB, s, 1e13f);
    } else if (stage == 1) {
        if (badv(bfa(MBP(bf16, MB_XA), row * DM + c), dotx(XN, row, W, c), 0.02f, 0.02f)) flag(DB, s, 1e12f);
        if (badv(bfa(MBP(bf16, MB_YA), row * DM + c), gelu_t(dotx(XN, row, W, 1024 + c)), 0.02f, 0.02f)) flag(DB, s, 1e12f);
        if (badv(bfa(MBP(bf16, MB_SB), row * DM + c), dotx(XN, row, W, 2048 + c), 0.02f, 0.02f)) flag(DB, s, 1e12f);
        { const size_t d0 = 3072 + 256 * (c >> 7) + (c & 127); if (badv(bfa(MBP(bf16, MB_SCSH), row * DM + c), dotx(XN, row, W, d0) * dotx(XN, row, W, d0 + 128), 0.03f, 0.03f)) flag(DB, s, 1e12f); }
        { const int h = c >> 8, d = c & 255, j = d & 127; const float cs = COS_[t * 128 + j], sn = SIN_[t * 128 + j];
          float q1 = dotx(XN, row, W, 5120 + h * 256 + j), q2 = dotx(XN, row, W, 5120 + h * 256 + 128 + j);
          if (badv(bfa(MBP(bf16, MB_Q), row * DM + c), d < 128 ? q1 * cs - q2 * sn : q1 * sn + q2 * cs, 0.02f, 0.03f)) flag(DB, s, 1e11f);
          q1 = dotx(XN, row, W, 8192 + h * 256 + j); q2 = dotx(XN, row, W, 8192 + h * 256 + 128 + j);
          const float ke = (d < 128 ? q1 * cs - q2 * sn : q1 * sn + q2 * cs) * 0.0625f;
          if (badv(bfa(MBP(bf16, MB_K), row * DM + c), ke, 0.02f, 0.003f)) flag(DB, s, 1e11f);
          if (badv(bfa(MBP(bf16, MB_KT), (size_t)c * M + row), ke, 0.02f, 0.003f)) flag(DB, s, 1e10f); }
        { const int cv = hh & 2047; if (badv(bfa(MBP(bf16, MB_G), row * 2048 + cv), silu_f(dotx(XN, row, W, 6144 + cv)), 0.02f, 0.02f)) flag(DB, s, 1e11f);
          if (badv(bfa(MBP(bf16, MB_VT), (size_t)cv * M + row), dotx(XN, row, W, 9216 + cv), 0.02f, 0.02f)) flag(DB, s, 1e10f); }
    } else if (stage == 2) {
        const int h = (s >> 8) & 3, e = hh & 511, n = t >> 6; const float gam = 1.0f - exp2f(-5.0f - (float)h);
        const bf16 *Q = MBP(bf16, MB_Q), *K = MBP(bf16, MB_K), *VT = MBP(bf16, MB_VT);
        if ((s & 15) == 0) {
            float acc = 0.f;
            for (int si = 0; si < (n + 1) * 64; ++si) { float d = 0.f; for (int x = 0; x < 256; ++x) d += bfa(Q, row * DM + h * 256 + x) * bfa(K, (rowb + si) * DM + h * 256 + x);
                const int dist = (si >> 6) == n ? (t > si ? t - si : si - t) : t - si; acc += powf(gam, (float)dist) * d * bfa(VT, (size_t)(h * 512 + e) * M + rowb + si); }
            const float sg = silu_f(dotx(XN, row, W, 6144 + h * 512 + e)); const float ex = acc * sg;
            float ssum = 0.f; for (int i = 0; i < 16; ++i) ssum += WSP(float, WS_SS)[(row * 4 + h) * 16 + i];
            const float rms = sqrtf(ssum / 512.f);
            float r5 = 0.05f, r3 = 0.03f; asm volatile("" : "+v"(r5), "+v"(r3));
            if (badv(bfa(MBP(bf16, MB_G), row * 2048 + h * 512 + e), ex, r5, r3 * rms * fabsf(sg) + 0.01f)) flag(DB, s, 1e9f);
        }
        { const float* cw = rd_ptr(P.pt, 17); float a = 0.f; for (int k = 0; k < 3; ++k) if (t - 2 + k >= 0) a += cw[k * DM + c] * bfa(MBP(bf16, MB_SCSH), (row - 2 + k) * DM + c);
          if (badv(bfa(MBP(bf16, MB_SB), row * DM + c), a * dotx(XN, row, W, 2048 + c), 0.03f, 0.03f)) flag(DB, s, 1e8f); }
    } else if (stage == 3) {
        if ((s & 15) == 1) {
            const int g = c >> 6, jo = c & 63; const bf16* XA = MBP(bf16, MB_XA);
            const float *cw = rd_ptr(P.pt, 8), *cb = rd_ptr(P.pt, 9), *wa = rd_ptr(P.pt, 10) + g * 4096, *wx = rd_ptr(P.pt, 12) + g * 4096;
            const float lam = rd_ptr(P.pt, 14)[c], sp = (-lam > 0.f ? -lam : 0.f) + log1pf(expf(-fabsf(lam)));
            float hst = 0.f;
            for (int si = 0; si <= t; ++si) {
                float rr = rd_ptr(P.pt, 11)[c], iv = rd_ptr(P.pt, 13)[c], xc = 0.f;
                for (int ci = 0; ci < 64; ++ci) { const int ch = g * 64 + ci; float xp = cb[ch];
                    for (int k = 0; k < 4; ++k) if (si - 3 + k >= 0) xp += cw[k * DM + ch] * bfa(XA, (rowb + si - 3 + k) * DM + ch);
                    rr += xp * wa[ci * 64 + jo]; iv += xp * wx[ci * 64 + jo]; if (ci == jo) xc = xp; }
                const float la = -8.0f * sigm(rr) * sp, a = expf(la); hst = a * hst + sqrtf(-expm1f(2.0f * la)) * sigm(iv) * xc;
            }
            if (badv(bfa(MBP(bf16, MB_YA), row * DM + c), hst * gelu_t(dotx(XN, row, W, 1024 + c)), 0.05f, 0.02f)) flag(DB, s, 1e7f);
        }
        { const int cg = hh % 3072; if (badv(bfa(MBP(bf16, MB_GATES), row * 3072 + cg), sigm(dotx(XN, row, W, 11264 + cg)), 0.02f, 0.01f)) flag(DB, s, 1e6f); }
        if ((s & 255) == 2) {
            const int h = (s >> 8) & 3; float sq = 0.f; int cnt = 0;
            for (int e = 0; e < 512; ++e) { const float gv = silu_f(dotx(XN, row, W, 6144 + h * 512 + e)); if (fabsf(gv) > 0.1f) { const float o = bfa(MBP(bf16, MB_G), row * 2048 + h * 512 + e) / gv; sq += o * o; ++cnt; } }
            if (cnt > 50 && badv(sq / cnt, 1.0f, 0.35f, 0.f)) flag(DB, s, 1e5f);
        }
    } else if (stage == 4) {
        float oa = 0.f, oc = 0.f, ob = 0.f;
        for (int j = 0; j < DM; ++j) { oa += bfa(MBP(bf16, MB_YA), row * DM + j) * bfa(WM_LRU_, (size_t)c * DM + j); oc += bfa(MBP(bf16, MB_SB), row * DM + j) * bfa(WM_SC_, (size_t)c * DM + j); }
        for (int j = 0; j < 2048; ++j) ob += bfa(MBP(bf16, MB_G), row * 2048 + j) * bfa(WM_RET_, (size_t)c * 2048 + j);
        const bf16* GT_ = MBP(bf16, MB_GATES);
        const float ex = bfa(GT_, row * 3072 + c) * oa + bfa(GT_, row * 3072 + 1024 + c) * ob + bfa(GT_, row * 3072 + 2048 + c) * oc;
        if (badv(bfa(MBP(bf16, MB_MIXB), row * DM + c), ex, 0.02f, 0.02f)) flag(DB, s, 1e4f);
    } else if (stage == 5) {
        float h = 0.f; for (int j = 0; j < DM; ++j) h += bfa(MBP(bf16, MB_MIXB), row * DM + j) * bfa(WM_OUT_, (size_t)c * DM + j);
        if (badv(bfa(MBP(bf16, MB_H), row * DM + c), h, 0.02f, 0.02f)) flag(DB, s, 1e3f);
    }
}
#endif
struct Args { const float* in[25]; float* out; unsigned char* ws; int ph_lo, ph_hi; };
constexpr int NPHASES = 1 + 12 * NL;

__global__ void __launch_bounds__(NTHREADS, 2) fwd_kernel(Args args) {
    extern __shared__ __attribute__((aligned(16))) unsigned char lds_raw[];
    LAS unsigned char* lds = (LAS unsigned char*)lds_raw;
    cg::grid_group grid = cg::this_grid();
    const int G = gridDim.x, bid = blockIdx.x, NGW = G * NWAVES, GT = G * NTHREADS;
    float* X = args.out;
    LAS unsigned long long* ptab = (LAS unsigned long long*)(lds + 131072);
    if (threadIdx.x == 0) {
#pragma unroll
        for (int i = 0; i < 25; ++i) ptab[i] = (unsigned long long)args.in[i];
    }
    __syncthreads();

#pragma unroll 1
    for (int ph = args.ph_lo; ph < args.ph_hi; ++ph) {
        size_t zoff = 0; asm volatile("" : "+s"(zoff));
        unsigned char* wsb = args.ws + zoff;
        const int l = ph == 0 ? 0 : (ph - 1) / 12, k = ph == 0 ? -1 : (ph - 1) % 12;
#if defined(SKIP_MIX)
        if (k >= 3 && k <= 8) continue;
#endif
        if (k == -1) {
#if EN & 1
            { PH_IDX;
            PREP_FFN(3, 4, 0); PREP_MIX(0);
            rope_tables((const int*)rd_ptr(ptab, 1), COS_, SIN_, gtid, GT);
            norm_phase(rd_ptr(ptab, 0), nullptr, 0.f, nullptr, IN_L(2, 0, DM), X, WSP(bf16, WS_XN), gw, NGW, lane);
            }
#endif
        } else if (k == 0 || k == 9) {
#if EN & 2
            pg8::Gemm g{WSP(bf16, WS_XN), WSP(bf16, WS_WF), M, 2 * DFF, DM}; pg8::StaticOrder S; S.init(M, 2 * DFF, G, bid);
            EpiSwiGLU E{MBP(bf16, MB_ACT)}; pg8::gemm_phase<EpiSwiGLU, pg8::StaticOrder, true, true>(lds, g, S, E);
#endif
        } else if (k == 1 || k == 10 || k == 7) {
#if EN & 4
            pg8::Gemm g{k == 7 ? MBP(bf16, MB_MIXB) : MBP(bf16, MB_ACT), k == 7 ? WM_OUT_ : WSP(bf16, WS_WF) + (size_t)2 * DFF * DM, M, DM, k == 7 ? DM : DFF}; pg8::StaticOrder S; S.init(M, DM, G, bid);
            EpiStore E{MBP(bf16, MB_H), DM}; pg8::gemm_phase<EpiStore, pg8::StaticOrder, true, true>(lds, g, S, E);
#endif
        } else if (k == 2) {
#if EN & 8
            { PH_IDX;
            norm_phase(X, MBP(bf16, MB_H), 0.5f, IN_L(5, l, DM), IN_L(6, l, DM), X, WSP(bf16, WS_XN), gw, NGW, lane);
            PREP_FFN(22, 23, l);
            }
#endif
        } else if (k == 3) {
#if EN & 16
            { pg8::Gemm g{WSP(bf16, WS_XN), WM_IN_, M, 5120, DM}; pg8::StaticOrder S; S.init(M, 5120, G, bid); EpiSet1 E{wsb + WS_MB};
              pg8::gemm_phase<EpiSet1, pg8::StaticOrder, true, true>(lds, g, S, E); }
#endif
#if EN & 1024
            { pg8::Gemm g{WSP(bf16, WS_XN), WM_IN_ + (size_t)5120 * DM, M, 4096, DM}; pg8::StaticOrder S; S.init(M, 4096, G, bid); EpiSet2n E{wsb + WS_MB, COS_, SIN_};
              pg8::gemm_phase<EpiSet2n, pg8::StaticOrder, true, true>(lds, g, S, E); }
#endif
#if EN & 2048
            { pg8::Gemm g{WM_IN_ + (size_t)8192 * DM, WSP(bf16, WS_XN), 3072, M, DM}; pg8::StaticOrder S; S.init(3072, M, G, bid); EpiSet2t E{MBP(bf16, MB_KT), MBP(bf16, MB_VT), COS_, SIN_};
              pg8::gemm_phase<EpiSet2t, pg8::StaticOrder, true, true>(lds, g, S, E); }
#endif
        } else if (k == 4) {
#if EN & 32
            { PH_IDX;
            retention_phase(lds, MBP(bf16, MB_Q), MBP(bf16, MB_K), MBP(bf16, MB_KT), MBP(bf16, MB_VT), MBP(bf16, MB_G), WSP(float, WS_SS), bid, G, tid);
            }
#endif
#if EN & 4096
            { PH_IDX;
            asm volatile("" ::: "memory"); __builtin_amdgcn_sched_barrier(0);
            lru_phase<false>(MBP(bf16, MB_XA), MBP(bf16, MB_YA), IN_L(8, l, 4 * DM), IN_L(9, l, DM), WAT_, WXT_, IN_L(11, l, DM), IN_L(13, l, DM), IN_L(14, l, DM), AGGA_, AGGH_, gw, NGW, lane);
            }
#endif
#if EN & 8192
            { PH_IDX;
            asm volatile("" ::: "memory"); __builtin_amdgcn_sched_barrier(0);
            ac_phase(MBP(bf16, MB_SB), MBP(bf16, MB_SCSH), IN_L(17, l, 3 * DM), gtid, GT);
            }
#endif
        } else if (k == 5) {
#if EN & 64
            { PH_IDX;
            lru_phase<true>(MBP(bf16, MB_XA), MBP(bf16, MB_YA), IN_L(8, l, 4 * DM), IN_L(9, l, DM), WAT_, WXT_, IN_L(11, l, DM), IN_L(13, l, DM), IN_L(14, l, DM), AGGA_, AGGH_, gw, NGW, lane);
            }
#endif
#if EN & 16384
            { PH_IDX;
            asm volatile("" ::: "memory"); __builtin_amdgcn_sched_barrier(0);
            retnorm_phase(MBP(bf16, MB_G), WSP(float, WS_SS), gw, NGW, lane);
            __syncthreads();
            }
#endif
#if EN & 32768
            pg8::Gemm g{WSP(bf16, WS_XN), WM_IN_ + (size_t)11264 * DM, M, 3072, DM}; pg8::StaticOrder S; S.init(M, 3072, G, bid); EpiGates E{MBP(bf16, MB_GATES)};
            pg8::gemm_phase<EpiGates, pg8::StaticOrder, true, true>(lds, g, S, E);
#endif
        } else if (k == 6) {
#if EN & 128
#pragma unroll 1
            for (int c = 0; c < 3; ++c) {
#if defined(DIAG) && DIAG < 4
                if (c != DIAG - 1) continue;
#endif
#if defined(SKIPC)
                if (c == SKIPC) continue;
#endif
                pg8::Gemm g{c == 0 ? MBP(bf16, MB_YA) : (c == 1 ? MBP(bf16, MB_SB) : MBP(bf16, MB_G)), c == 0 ? WM_LRU_ : (c == 1 ? WM_SC_ : WM_RET_), M, DM, c == 2 ? 2048 : DM}; pg8::StaticOrder S; S.init(M, DM, G, bid);
                EpiMix E{MBP(bf16, MB_GATES), MBP(float, MB_MIX), MBP(bf16, MB_MIXB), c == 0 ? 0 : (c == 1 ? 2048 : 1024),
#if defined(DIAG)
                    3
#elif defined(SKIPC)
                    (SKIPC == 0 ? (c == 1 ? 0 : 2) : (SKIPC == 1 ? (c == 0 ? 0 : 2) : (c == 0 ? 0 : 4)))
#else
                    c
#endif
                };
                pg8::gemm_phase<EpiMix, pg8::StaticOrder, true, true>(lds, g, S, E);
                __builtin_amdgcn_fence(__ATOMIC_SEQ_CST, "agent");
                __syncthreads();
            }
#endif
        } else if (k == 8) {
#if EN & 256
            { PH_IDX;
            norm_phase(X, MBP(bf16, MB_H), 1.0f, IN_L(20, l, DM), IN_L(21, l, DM), X, WSP(bf16, WS_XN), gw, NGW, lane);
            }
#endif
        } else if (k == 11) {
#if EN & 512
            { PH_IDX;
            if (l + 1 < NL) {
                norm_phase(X, MBP(bf16, MB_H), 0.5f, IN_L(24, l, DM), IN_L(2, l + 1, DM), X, WSP(bf16, WS_XN), gw, NGW, lane);
                PREP_FFN(3, 4, l + 1); PREP_MIX(l + 1);
            } else norm_phase(X, MBP(bf16, MB_H), 0.5f, IN_L(24, l, DM), nullptr, X, WSP(bf16, WS_XN), gw, NGW, lane);
            }
#endif
        }
        if (ph + 1 < args.ph_hi) {
            __builtin_amdgcn_fence(__ATOMIC_RELEASE, "agent"); asm volatile("s_waitcnt vmcnt(0)" ::: "memory");
            grid.sync();
            __builtin_amdgcn_fence(__ATOMIC_ACQUIRE, "agent"); asm volatile("s_waitcnt vmcnt(0)" ::: "memory");
            __syncthreads();
        }
#if defined(CHECK)
        {
            int stage = -1;
            if (ph == 0) stage = 0; else if (ph == 4) stage = 1; else if (ph == 5) stage = 2; else if (ph == 6) stage = 3; else if (ph == 7) stage = 4; else if (ph == 8) stage = 5;
            if (stage >= 0) {
                PH_IDX;
                float* DB = (float*)(wsb + WS_END);
                if (stage == 0) DB[gtid] = 0.f;
                ChkP P; P.pt = ptab; P.wsb = wsb; P.DB = DB;
                chk_stage(P, stage, gtid);
                if (stage == 5) {
                    grid.sync();
                    for (size_t i = gtid; i < (size_t)M * DM; i += GT) X[i] = 0.f;
                    grid.sync();
                    X[(size_t)gtid * 128] = DB[gtid];
                    if (gtid == 0) X[1] = 3000.f;
                    return;
                }
                grid.sync();
            }
        }
#endif
    }
}

#ifndef ONE_LAUNCH
#define ONE_LAUNCH 1
#endif
extern "C" void kernel_launch(void* const* d_in, const int* in_sizes, int n_in, void* d_out, int out_size, void* d_ws, size_t ws_size, hipStream_t stream) {
    static int ready = 0;
    if (ready == 0) {
        if (n_in != 25 || out_size != M * DM || ws_size < WS_END + 512 * KiB) { fprintf(stderr, "kernel_launch: unexpected problem (n_in %d out %d ws %zu need %zu)\n", n_in, out_size, ws_size, (size_t)WS_END); ready = -1; return; }
        if (hipFuncSetAttribute((const void*)fwd_kernel, hipFuncAttributeMaxDynamicSharedMemorySize, LDS_BYTES) != hipSuccess) { fprintf(stderr, "kernel_launch: hipFuncSetAttribute failed\n"); ready = -1; return; }
        int dev = 0, cus = 0, per_cu = 0;
        hipGetDevice(&dev); hipDeviceGetAttribute(&cus, hipDeviceAttributeMultiprocessorCount, dev);
        hipOccupancyMaxActiveBlocksPerMultiprocessor(&per_cu, (const void*)fwd_kernel, NTHREADS, LDS_BYTES);
        if (per_cu < 1) { fprintf(stderr, "kernel_launch: occupancy query says %d blocks per CU\n", per_cu); }
        (void)hipGetLastError();
        ready = cus > 0 ? cus : 256;
    }
    if (ready < 0) return;
    Args a{};
    for (int i = 0; i < 25; ++i) a.in[i] = (const float*)d_in[i];
    a.out = (float*)d_out; a.ws = (unsigned char*)d_ws;
#if ONE_LAUNCH
    a.ph_lo = 0; a.ph_hi = NPHASES;
    void* kargs[] = {&a};
    hipError_t e = hipLaunchCooperativeKernel((const void*)fwd_kernel, dim3(ready), dim3(NTHREADS), kargs, LDS_BYTES, stream);
    if (e != hipSuccess) fprintf(stderr, "cooperative launch failed: %s\n", hipGetErrorString(e));
#else
    for (int ph = 0; ph < NPHASES; ++ph) { a.ph_lo = ph; a.ph_hi = ph + 1; hipLaunchKernelGGL(fwd_kernel, dim3(ready), dim3(NTHREADS), LDS_BYTES, stream, a); }
#endif
}
```

```cpp
#include <hip/hip_runtime.h>
#include <hip/hip_cooperative_groups.h>
#include <cstdio>
#include <cstdint>
namespace cg = cooperative_groups;
#ifndef EN
#define EN 65535
#endif
namespace pg8 {
#define PG8_LAS __attribute__((address_space(3)))
typedef unsigned short bf16_t;
typedef short bf16x8 __attribute__((ext_vector_type(8)));
typedef float f32x4 __attribute__((ext_vector_type(4)));
typedef unsigned u32x4 __attribute__((ext_vector_type(4)));
constexpr int BM = 256, BK = 64, HALF = 128, HTB = HALF * BK * 2  , STAGE_BYTES = 8 * HTB, NXCD = 8, WGM = 8;

__host__ __device__ __forceinline__ int lds_byte(int r, int c) { const int st = (r >> 4) * 2 + (c >> 5), rr = r & 15, cc = c & 31, ob = rr * 64 + cc * 2; return st * 1024 + (ob ^ (((ob >> 9) & 1) << 5)); }
__host__ __device__ __forceinline__ void stage_rc(int b, int& R, int& C) { const int st = b / 1024, sb = b % 1024, swz = sb ^ (((sb >> 9) & 1) << 5); R = (st >> 1) * 16 + swz / 64; C = (st & 1) * 32 + (swz % 64) / 2; }
__host__ __device__ __forceinline__ int perm32(int rho) { const int n = rho >> 4, i = rho & 15; return 8 * (i >> 2) + 4 * n + (i & 3); }

struct Unit { int pm, pn; };
struct Gemm { const bf16_t* A; const bf16_t* Bt; int M, N, K; };

struct StaticOrder {
    int nM, nN, nwg, G, c;
    __host__ __device__ void init(int M, int N, int G_, int c_) { nM = M / BM; nN = N / BM; nwg = nM * nN; G = G_; c = c_; }
    __host__ __device__ bool next(int i, Unit& u) const {
        const long L = (long)i * G + c; if (L >= nwg) return false;
        int wgid = (int)L; { const int q = nwg / NXCD, r = nwg % NXCD, xcd = wgid % NXCD, off = wgid / NXCD; wgid = (xcd < r ? xcd * (q + 1) : r * (q + 1) + (xcd - r) * q) + off; }
        const int nig = WGM * nN, gid = wgid / nig, fm = gid * WGM, gsz = (nM - fm) < WGM ? (nM - fm) : WGM;
        u.pm = fm + ((wgid % nig) % gsz); u.pn = (wgid % nig) / gsz; return true;
    }
    __device__ __forceinline__ void a_ready(const Unit&) const {}
    __device__ __forceinline__ void done(const Unit&) const {}
};

__device__ __forceinline__ unsigned cvt_pk_bf16(float lo, float hi) { unsigned r; asm volatile("v_cvt_pk_bf16_f32 %0, %1, %2" : "=v"(r) : "v"(lo), "v"(hi)); return r; }
typedef float f32x2 __attribute__((ext_vector_type(2)));
__device__ __forceinline__ f32x2 gelu_pk(f32x2 v) {
    const f32x2 av = __builtin_elementwise_abs(v), d = av * 0.2316418882f + 1.0f;
    f32x2 t; t.x = __builtin_amdgcn_rcpf(d.x); t.y = __builtin_amdgcn_rcpf(d.y);
    f32x2 q = t * 0.5307027145f + (-0.7265760135f); q = q * t + 0.7107068705f; q = q * t + (-0.142248368f); q = q * t + 0.127414796f; q = q * t;
    const f32x2 s = (v * v) * (-0.72134752044f);
    f32x2 e; e.x = __builtin_amdgcn_exp2f(s.x); e.y = __builtin_amdgcn_exp2f(s.y);
    const f32x2 m = v * (q * e), r = v - m;
    f32x2 o; o.x = v.x < 0.f ? m.x : r.x; o.y = v.y < 0.f ? m.y : r.y; return o;
}

template <int ACT  > struct EpiBf16 {
    static constexpr bool PERM = true, AFTER_DRAIN = false; static_assert(ACT == 0 || ACT == 1, "EpiBf16: ACT is 0 (none) or 1 (gelu_pk)");
    bf16_t* O; int ldc; const float* bias; int split_cols; size_t split_stride; float scale0;
    __device__ __forceinline__ void operator()(const f32x4 (&acc)[2][2][4][2], const Unit& u, int wr, int wc, int fr, int fq) const {
        const int row0 = u.pm * BM + wr * 64 + fr; int colt = u.pn * BM; bf16_t* base = O;
        float sc = 1.f; if (split_cols) { const int t = colt / split_cols; base += (size_t)t * split_stride; colt -= t * split_cols; if (t == 0) sc = scale0; }
        const int col0 = colt + wc * 32 + 8 * fq, bcol0 = u.pn * BM + wc * 32 + 8 * fq;
        f32x4 bv[2][2];
#pragma unroll
        for (int bj = 0; bj < 2; ++bj)
#pragma unroll
            for (int n = 0; n < 2; ++n) bv[bj][n] = bias ? *(const f32x4*)(bias + bcol0 + bj * HALF + 4 * n) : (f32x4){0.f, 0.f, 0.f, 0.f};
#pragma unroll
        for (int ai = 0; ai < 2; ++ai)
#pragma unroll
            for (int m = 0; m < 4; ++m) { bf16_t* rowp = base + (size_t)(row0 + ai * HALF + m * 16) * ldc + col0;
#pragma unroll
                for (int bj = 0; bj < 2; ++bj) { f32x4 v0 = acc[ai][bj][m][0] + bv[bj][0], v1 = acc[ai][bj][m][1] + bv[bj][1];
                    if (ACT == 1) { f32x2 a = gelu_pk((f32x2){v0[0], v0[1]}), b = gelu_pk((f32x2){v0[2], v0[3]}), c = gelu_pk((f32x2){v1[0], v1[1]}), d = gelu_pk((f32x2){v1[2], v1[3]});
                        v0 = (f32x4){a.x, a.y, b.x, b.y}; v1 = (f32x4){c.x, c.y, d.x, d.y}; }
                    v0 = v0 * sc; v1 = v1 * sc; u32x4 w; w.x = cvt_pk_bf16(v0[0], v0[1]); w.y = cvt_pk_bf16(v0[2], v0[3]); w.z = cvt_pk_bf16(v1[0], v1[1]); w.w = cvt_pk_bf16(v1[2], v1[3]);
                    *(u32x4*)(rowp + bj * HALF) = w; } }
    }
};
template <class Epi, class Sched, bool ALIGN_EPI = false, bool SP2 = false>
__device__ __forceinline__ void gemm_phase(PG8_LAS unsigned char* lds, const Gemm g, const Sched& S, const Epi& E) {
    int tid_l = threadIdx.x; asm volatile("" : "+v"(tid_l));
    const int tid = tid_l, wid = __builtin_amdgcn_readfirstlane(tid >> 6), lane = tid & 63, wr = wid >> 2, wc = wid & 3, fr = lane & 15, fq = lane >> 4;
    const int K = g.K, nt = K / BK;
    unsigned voffA[2], voffB[2];
#pragma unroll
    for (int i = 0; i < 2; ++i) { int R, C; stage_rc(tid * 16 + i * 8192, R, C); const int Rb = Epi::PERM ? ((R & ~31) + perm32(R & 31)) : R;
        voffA[i] = (unsigned)(R * K + C) * 2u; voffB[i] = (unsigned)(Rb * K + C) * 2u; }
    const size_t kstep = (size_t)(BK * 2);
    const size_t hstep = (size_t)HALF * K * 2;
    const size_t tstep = 2 * hstep;
    const unsigned ldsw = (unsigned)wid * 1024u;
    const int aoff = lds_byte(wr * 64 + fr, fq * 8), boff = lds_byte(wc * 32 + fr, fq * 8);
#define PG8_SA(b, h) (((b) * 2 + (h)) * HTB)
#define PG8_SB(b, h) ((4 + (b) * 2 + (h)) * HTB)
#define PG8_STAGE(bufoff, gbase, voff) do { _Pragma("unroll") for (int _i = 0; _i < 2; ++_i) \
        __builtin_amdgcn_global_load_lds((const unsigned*)((const char*)(gbase) + (voff)[_i]), (PG8_LAS unsigned*)(lds + (bufoff) + ldsw + _i * 8192), 16, 0, 0); } while (0)
#define PG8_LDA(dst, b, h) do { _Pragma("unroll") for (int m = 0; m < 4; ++m) _Pragma("unroll") for (int k = 0; k < 2; ++k) dst[m][k] = *(const PG8_LAS bf16x8*)(lds + PG8_SA(b, h) + aoff + m * 2048 + k * 1024); } while (0)
#define PG8_LDB(dst, b, h) do { _Pragma("unroll") for (int n = 0; n < 2; ++n) _Pragma("unroll") for (int k = 0; k < 2; ++k) dst[n][k] = *(const PG8_LAS bf16x8*)(lds + PG8_SB(b, h) + boff + n * 2048 + k * 1024); } while (0)
#define PG8_MMA(ai, bj, At, Bt) do { __builtin_amdgcn_s_setprio(1); _Pragma("unroll") for (int m = 0; m < 4; ++m) _Pragma("unroll") for (int n = 0; n < 2; ++n) _Pragma("unroll") for (int k = 0; k < 2; ++k) \
        acc[ai][bj][m][n] = __builtin_amdgcn_mfma_f32_16x16x32_bf16(Bt[n][k], At[m][k], acc[ai][bj][m][n], 0, 0, 0); __builtin_amdgcn_s_setprio(0); } while (0)
#define PG8_WAIT_V(n) asm volatile("s_waitcnt vmcnt(" #n ")" ::: "memory")
#define PG8_WAIT_L(n) asm volatile("s_waitcnt lgkmcnt(" #n ")" ::: "memory")
#define PG8_BAR __builtin_amdgcn_s_barrier()
#define PG8_SCHED __builtin_amdgcn_sched_barrier(0)
    Unit cur, nxt; int ui = 0;
    if (!S.next(0, cur)) return;
    f32x4 acc[2][2][4][2];
#pragma unroll
    for (int a = 0; a < 2; ++a)
#pragma unroll
        for (int b = 0; b < 2; ++b)
#pragma unroll
            for (int m = 0; m < 4; ++m)
#pragma unroll
                for (int n = 0; n < 2; ++n) acc[a][b][m][n] = (f32x4){0.f, 0.f, 0.f, 0.f};
    bf16x8 At[4][2], B0[2][2], B1[2][2];
    const char* cA = (const char*)g.A + (size_t)cur.pm * tstep; const char* cB = (const char*)g.Bt + (size_t)cur.pn * tstep;
    S.a_ready(cur);
    if constexpr (SP2) {
        PG8_STAGE(PG8_SB(0, 0), cB, voffB); PG8_STAGE(PG8_SB(0, 1), cB + hstep, voffB); PG8_STAGE(PG8_SA(0, 0), cA, voffA); PG8_STAGE(PG8_SA(0, 1), cA + hstep, voffA);
        if (wr == 1) PG8_BAR;
        PG8_WAIT_V(2); PG8_BAR;
        PG8_STAGE(PG8_SB(1, 0), cB + kstep, voffB); PG8_STAGE(PG8_SA(1, 0), cA + kstep, voffA); PG8_STAGE(PG8_SB(1, 1), cB + hstep + kstep, voffB);
        PG8_WAIT_V(6); PG8_BAR;
    } else {
        PG8_STAGE(PG8_SB(0, 0), cB, voffB); PG8_STAGE(PG8_SA(0, 0), cA, voffA); PG8_STAGE(PG8_SB(0, 1), cB + hstep, voffB); PG8_STAGE(PG8_SA(0, 1), cA + hstep, voffA);
        if (wr == 1) PG8_BAR;
        PG8_WAIT_V(4); PG8_BAR;
        PG8_STAGE(PG8_SB(1, 0), cB + kstep, voffB); PG8_STAGE(PG8_SA(1, 0), cA + kstep, voffA); PG8_STAGE(PG8_SB(1, 1), cB + hstep + kstep, voffB);
        PG8_WAIT_V(6); PG8_BAR;
    }
    for (;;) {
        const bool has_next = S.next(ui + 1, nxt);
        const char* nA = has_next ? (const char*)g.A + (size_t)nxt.pm * tstep : cA; const char* nB = has_next ? (const char*)g.Bt + (size_t)nxt.pn * tstep : cB;
        for (int t = 0; t < nt; t += 2) {
            const bool last = (t == nt - 2);
            const char* a1 = cA + (size_t)(t + 1) * kstep;
            const char* a2 = last ? nA : cA + (size_t)(t + 2) * kstep; const char* b2 = last ? nB : cB + (size_t)(t + 2) * kstep;
            const char* a3 = a2 + kstep; const char* b3 = b2 + kstep;
            if (last && has_next) S.a_ready(nxt);
            if constexpr (SP2) {
            PG8_LDB(B0, 0, 0); PG8_LDB(B1, 0, 1); PG8_SCHED; PG8_LDA(At, 0, 0); PG8_STAGE(PG8_SA(1, 1), a1 + hstep, voffA);
            PG8_WAIT_V(8); PG8_WAIT_L(0); PG8_BAR; PG8_MMA(0, 0, At, B0); PG8_MMA(0, 1, At, B1); PG8_BAR; PG8_SCHED;
            PG8_LDA(At, 0, 1); PG8_STAGE(PG8_SB(0, 0), b2, voffB); PG8_STAGE(PG8_SB(0, 1), b2 + hstep, voffB); PG8_STAGE(PG8_SA(0, 0), a2, voffA);
            PG8_WAIT_V(8); PG8_WAIT_L(0); PG8_BAR; PG8_MMA(1, 0, At, B0); PG8_MMA(1, 1, At, B1); PG8_BAR; PG8_SCHED;
            PG8_LDB(B0, 1, 0); PG8_LDB(B1, 1, 1); PG8_SCHED; PG8_LDA(At, 1, 0); PG8_STAGE(PG8_SA(0, 1), a2 + hstep, voffA);
            PG8_WAIT_V(8); PG8_WAIT_L(0); PG8_BAR; PG8_MMA(0, 0, At, B0); PG8_MMA(0, 1, At, B1); PG8_BAR; PG8_SCHED;
            PG8_LDA(At, 1, 1); PG8_STAGE(PG8_SB(1, 0), b3, voffB); PG8_STAGE(PG8_SB(1, 1), b3 + hstep, voffB); PG8_STAGE(PG8_SA(1, 0), a3, voffA);
            PG8_WAIT_V(8); PG8_WAIT_L(0); PG8_BAR; PG8_MMA(1, 0, At, B0); PG8_MMA(1, 1, At, B1); PG8_BAR; PG8_SCHED;
            } else {
            PG8_LDB(B0, 0, 0); PG8_SCHED; PG8_LDA(At, 0, 0); PG8_STAGE(PG8_SA(1, 1), a1 + hstep, voffA);
            PG8_WAIT_L(8); PG8_BAR; PG8_WAIT_L(0); PG8_MMA(0, 0, At, B0); PG8_BAR; PG8_SCHED;
            PG8_LDB(B1, 0, 1); PG8_STAGE(PG8_SB(0, 0), b2, voffB);
            PG8_BAR; PG8_WAIT_L(0); PG8_MMA(0, 1, At, B1); PG8_BAR;
            PG8_LDA(At, 0, 1); PG8_STAGE(PG8_SA(0, 0), a2, voffA);
            PG8_BAR; PG8_WAIT_L(0); PG8_MMA(1, 0, At, B0); PG8_BAR; PG8_SCHED;
            PG8_STAGE(PG8_SB(0, 1), b2 + hstep, voffB);
            PG8_WAIT_V(6); PG8_BAR; PG8_MMA(1, 1, At, B1); PG8_BAR;
            PG8_LDB(B0, 1, 0); PG8_SCHED; PG8_LDA(At, 1, 0); PG8_STAGE(PG8_SA(0, 1), a2 + hstep, voffA);
            PG8_WAIT_L(8); PG8_BAR; PG8_WAIT_L(0); PG8_MMA(0, 0, At, B0); PG8_BAR; PG8_SCHED;
            PG8_LDB(B1, 1, 1); PG8_STAGE(PG8_SB(1, 0), b3, voffB);
            PG8_BAR; PG8_WAIT_L(0); PG8_MMA(0, 1, At, B1); PG8_BAR;
            PG8_LDA(At, 1, 1); PG8_STAGE(PG8_SA(1, 0), a3, voffA);
            PG8_BAR; PG8_WAIT_L(0); PG8_MMA(1, 0, At, B0); PG8_BAR; PG8_SCHED;
            PG8_STAGE(PG8_SB(1, 1), b3 + hstep, voffB);
            PG8_WAIT_V(6); PG8_BAR; PG8_MMA(1, 1, At, B1); PG8_BAR;
            }
        }
        if constexpr (ALIGN_EPI) { if (wr == 0) PG8_BAR; }
        if constexpr (!Epi::AFTER_DRAIN) { E(acc, cur, wr, wc, fr, fq); S.done(cur); }
        if (!has_next) break;
#pragma unroll
        for (int a = 0; a < 2; ++a)
#pragma unroll
            for (int b = 0; b < 2; ++b)
#pragma unroll
                for (int m = 0; m < 4; ++m)
#pragma unroll
                    for (int n = 0; n < 2; ++n) acc[a][b][m][n] = (f32x4){0.f, 0.f, 0.f, 0.f};
        cur = nxt; cA = nA; cB = nB; ++ui;
        if constexpr (ALIGN_EPI) { if (wr == 1) PG8_BAR; }
    }
    PG8_WAIT_V(0);
    if constexpr (!ALIGN_EPI) { if (wr == 0) PG8_BAR; }
    PG8_BAR;
    if constexpr (Epi::AFTER_DRAIN) { E.fused(acc, cur, wr, wc, fr, fq, lds, wid, lane); S.done(cur); }
#undef PG8_SA
#undef PG8_SB
#undef PG8_STAGE
#undef PG8_LDA
#undef PG8_LDB
#undef PG8_MMA
#undef PG8_WAIT_V
#undef PG8_WAIT_L
#undef PG8_BAR
#undef PG8_SCHED
}
}

#define LAS __attribute__((address_space(3)))
typedef unsigned short bf16;
typedef unsigned u32x4 __attribute__((ext_vector_type(4)));
typedef unsigned u32x2 __attribute__((ext_vector_type(2)));
typedef float f32x4 __attribute__((ext_vector_type(4)));
typedef short bf16x8 __attribute__((ext_vector_type(8)));

constexpr int DM = 1024, SEQ = 2048, NB = 8, M = NB * SEQ, DFF = 2816, NL = 2, MIXIN = 14336;
constexpr float EPS = 1e-6f;
constexpr int NWAVES = 8, NTHREADS = 512;
constexpr int LDS_BYTES = 147456;

constexpr size_t KiB = 1024, MiB = 1024 * 1024;
constexpr size_t WS_LRUW = 256 * KiB;
constexpr size_t WS_AGG  = 512 * KiB;
constexpr size_t WS_SS   = WS_AGG + 2 * MiB;
constexpr size_t WS_ROPE = WS_SS + 4 * MiB;
constexpr size_t WS_WF   = WS_ROPE + 2 * MiB;
constexpr size_t WS_WM   = WS_WF + 16 * MiB + 512 * KiB;
constexpr size_t WS_XN   = WS_WM + 38 * MiB;
constexpr size_t WS_MB   = WS_XN + 32 * MiB;
constexpr size_t WS_END  = WS_MB + 352 * MiB;
constexpr size_t MB_YA = 0, MB_SB = 32 * MiB, MB_XA = 64 * MiB, MB_SCSH = 96 * MiB, MB_Q = 128 * MiB, MB_K = 160 * MiB, MB_KT = 192 * MiB,
                 MB_VT = 224 * MiB, MB_G = 288 * MiB, MB_GATES = 128 * MiB, MB_MIX = 224 * MiB, MB_MIXB = 64 * MiB, MB_H = 96 * MiB, MB_ACT = 128 * MiB;

__device__ __forceinline__ unsigned f2bf(float f) { unsigned u = __builtin_bit_cast(unsigned, f); return (u + 0x7fffu + ((u >> 16) & 1u)) >> 16; }
__device__ __forceinline__ unsigned pk2(float lo, float hi) { return f2bf(lo) | (f2bf(hi) << 16); }
__device__ __forceinline__ float bflo(unsigned u) { return __builtin_bit_cast(float, u << 16); }
__device__ __forceinline__ float bfhi(unsigned u) { return __builtin_bit_cast(float, u & 0xffff0000u); }
__device__ __forceinline__ float sigm(float x) { return __builtin_amdgcn_rcpf(1.f + __builtin_amdgcn_exp2f(-1.4426950408889634f * x)); }
__device__ __forceinline__ float silu_f(float x) { return x * sigm(x); }
__device__ __forceinline__ float gelu_t(float x) { return x * sigm(1.5957691216057308f * (x + 0.044715f * x * x * x)); }
__device__ __forceinline__ void st8(bf16* p, f32x4 a, f32x4 b) {
    u32x4 w;
    asm volatile("s_nop 1\n\tv_cvt_pk_bf16_f32 %0, %4, %5\n\tv_cvt_pk_bf16_f32 %1, %6, %7\n\tv_cvt_pk_bf16_f32 %2, %8, %9\n\tv_cvt_pk_bf16_f32 %3, %10, %11"
                 : "=&v"(w.x), "=&v"(w.y), "=&v"(w.z), "=&v"(w.w)
                 : "v"(a[0]), "v"(a[1]), "v"(a[2]), "v"(a[3]), "v"(b[0]), "v"(b[1]), "v"(b[2]), "v"(b[3]));
    *(u32x4*)p = w;
}
__device__ __forceinline__ float wave_sum(float v) {
#pragma unroll
    for (int o = 1; o < 64; o <<= 1) v += __shfl_xor(v, o);
    return v;
}
#define LDS_WAIT() asm volatile("s_waitcnt lgkmcnt(0)" ::: "memory")
__device__ __forceinline__ const float* rd_ptr(LAS const unsigned long long* t, int i) {
    const unsigned long long v = t[i]; const unsigned lo = __builtin_amdgcn_readfirstlane((unsigned)v), hi = __builtin_amdgcn_readfirstlane((unsigned)(v >> 32));
    typedef __attribute__((address_space(1))) const float* gptr_t;
    return (const float*)(gptr_t)(((unsigned long long)hi << 32) | lo);
}

using pg8::Unit;
#define EPI_IDX int t__ = threadIdx.x; asm volatile("" : "+v"(t__)); const int wr = t__ >> 8, wc = (t__ >> 6) & 3, fr = t__ & 15, fq = (t__ >> 4) & 3; (void)wr_; (void)wc_; (void)fr_; (void)fq_
typedef const f32x4 (&AccRef)[2][2][4][2];

struct EpiSwiGLU {
    static constexpr bool PERM = true, AFTER_DRAIN = false; bf16* O;
    __device__ __forceinline__ void operator()(AccRef acc, const Unit& u, int wr_, int wc_, int fr_, int fq_) const {
        EPI_IDX;
        const int row0 = u.pm * 256 + wr * 64 + fr, col0 = u.pn * 128 + wc * 32 + 8 * fq;
#pragma unroll
        for (int ai = 0; ai < 2; ++ai)
#pragma unroll
            for (int m = 0; m < 4; ++m) {
                f32x4 o0, o1;
#pragma unroll
                for (int i = 0; i < 4; ++i) { o0[i] = silu_f(acc[ai][0][m][0][i]) * acc[ai][1][m][0][i]; o1[i] = silu_f(acc[ai][0][m][1][i]) * acc[ai][1][m][1][i]; }
                st8(O + (size_t)(row0 + ai * 128 + m * 16) * DFF + col0, o0, o1);
            }
    }
};
struct EpiStore {
    static constexpr bool PERM = true, AFTER_DRAIN = false; bf16* O; int ldc;
    __device__ __forceinline__ void operator()(AccRef acc, const Unit& u, int wr_, int wc_, int fr_, int fq_) const {
        EPI_IDX;
        const int row0 = u.pm * 256 + wr * 64 + fr, col0 = u.pn * 256 + wc * 32 + 8 * fq;
#pragma unroll
        for (int ai = 0; ai < 2; ++ai)
#pragma unroll
            for (int m = 0; m < 4; ++m)
#pragma unroll
                for (int bj = 0; bj < 2; ++bj) st8(O + (size_t)(row0 + ai * 128 + m * 16) * ldc + col0 + bj * 128, acc[ai][bj][m][0], acc[ai][bj][m][1]);
    }
};
struct EpiSet1 {
    static constexpr bool PERM = true, AFTER_DRAIN = false; unsigned char* mb;
    __device__ __forceinline__ void operator()(AccRef acc, const Unit& u, int wr_, int wc_, int fr_, int fq_) const {
        EPI_IDX;
        const int row0 = u.pm * 256 + wr * 64 + fr;
        if (u.pn < 12) {
            const int t = u.pn >> 2; bf16* base = (bf16*)(mb + (size_t)((t + 2) % 3) * (32 * MiB)); const int col0 = (u.pn & 3) * 256 + wc * 32 + 8 * fq;
#pragma unroll
            for (int ai = 0; ai < 2; ++ai)
#pragma unroll
                for (int m = 0; m < 4; ++m)
#pragma unroll
                    for (int bj = 0; bj < 2; ++bj) {
                        f32x4 v0 = acc[ai][bj][m][0], v1 = acc[ai][bj][m][1];
                        if (t == 1) {
#pragma unroll
                            for (int i = 0; i < 4; ++i) { v0[i] = gelu_t(v0[i]); v1[i] = gelu_t(v1[i]); }
                        }
                        st8(base + (size_t)(row0 + ai * 128 + m * 16) * DM + col0 + bj * 128, v0, v1);
                    }
        } else {
            const int col0 = (u.pn - 12) * 128 + wc * 32 + 8 * fq;
#pragma unroll
            for (int ai = 0; ai < 2; ++ai)
#pragma unroll
                for (int m = 0; m < 4; ++m) st8((bf16*)(mb + MB_SCSH) + (size_t)(row0 + ai * 128 + m * 16) * DM + col0, acc[ai][0][m][0] * acc[ai][1][m][0], acc[ai][0][m][1] * acc[ai][1][m][1]);
        }
    }
};
struct EpiSet2n {
    static constexpr bool PERM = true, AFTER_DRAIN = false; unsigned char* mb; const float *COS, *SIN;
    __device__ __forceinline__ void operator()(AccRef acc, const Unit& u, int wr_, int wc_, int fr_, int fq_) const {
        EPI_IDX;
        const int row0 = u.pm * 256 + wr * 64 + fr;
        if (u.pn >= 4 && u.pn < 12) {
            const int col0 = (u.pn - 4) * 256 + wc * 32 + 8 * fq;
#pragma unroll
            for (int ai = 0; ai < 2; ++ai)
#pragma unroll
                for (int m = 0; m < 4; ++m)
#pragma unroll
                    for (int bj = 0; bj < 2; ++bj) {
                        f32x4 v0 = acc[ai][bj][m][0], v1 = acc[ai][bj][m][1];
#pragma unroll
                        for (int i = 0; i < 4; ++i) { v0[i] = silu_f(v0[i]); v1[i] = silu_f(v1[i]); }
                        st8((bf16*)(mb + MB_G) + (size_t)(row0 + ai * 128 + m * 16) * 2048 + col0 + bj * 128, v0, v1);
                    }
        } else {
            const bool isk = u.pn >= 12; const int h = u.pn & 3; bf16* base = (bf16*)(mb + MB_Q + (isk ? 32 * MiB : 0)); const float sc = isk ? 0.0625f : 1.0f;
            const int j0 = wc * 32 + 8 * fq;
#pragma unroll
            for (int ai = 0; ai < 2; ++ai)
#pragma unroll
                for (int m = 0; m < 4; ++m) {
                    const int row = row0 + ai * 128 + m * 16, t = row & (SEQ - 1);
                    const f32x4 c0 = *(const f32x4*)(COS + t * 128 + j0), c1 = *(const f32x4*)(COS + t * 128 + j0 + 4);
                    const f32x4 s0 = *(const f32x4*)(SIN + t * 128 + j0), s1 = *(const f32x4*)(SIN + t * 128 + j0 + 4);
                    const f32x4 a0 = acc[ai][0][m][0], a1 = acc[ai][0][m][1], b0 = acc[ai][1][m][0], b1 = acc[ai][1][m][1];
                    bf16* p = base + (size_t)row * DM + h * 256 + j0;
                    st8(p, (a0 * c0 - b0 * s0) * sc, (a1 * c1 - b1 * s1) * sc);
                    st8(p + 128, (a0 * s0 + b0 * c0) * sc, (a1 * s1 + b1 * c1) * sc);
                    asm volatile("" ::: "memory");
                }
        }
    }
};
struct EpiSet2t {
    static constexpr bool PERM = true, AFTER_DRAIN = false; bf16 *KT, *VT; const float *COS, *SIN;
    __device__ __forceinline__ void operator()(AccRef acc, const Unit& u, int wr_, int wc_, int fr_, int fq_) const {
        EPI_IDX;
        const int tok0 = u.pn * 256 + wc * 32 + 8 * fq;
        if (u.pm >= 4) {
            const int ch0 = (u.pm - 4) * 256 + wr * 64 + fr;
#pragma unroll
            for (int ai = 0; ai < 2; ++ai)
#pragma unroll
                for (int m = 0; m < 4; ++m)
#pragma unroll
                    for (int bj = 0; bj < 2; ++bj) st8(VT + (size_t)(ch0 + ai * 128 + m * 16) * M + tok0 + bj * 128, acc[ai][bj][m][0], acc[ai][bj][m][1]);
        } else {
#pragma unroll
            for (int m = 0; m < 4; ++m) {
                const int j = wr * 64 + m * 16 + fr;
#pragma unroll
                for (int bj = 0; bj < 2; ++bj) {
                    f32x4 o1[2], o2[2];
#pragma unroll
                    for (int n = 0; n < 2; ++n)
#pragma unroll
                        for (int i = 0; i < 4; ++i) {
                            const int t = (tok0 + bj * 128 + 4 * n + i) & (SEQ - 1);
                            const float c = COS[t * 128 + j], s = SIN[t * 128 + j];
                            const float a = acc[0][bj][m][n][i], b = acc[1][bj][m][n][i];
                            o1[n][i] = (a * c - b * s) * 0.0625f; o2[n][i] = (a * s + b * c) * 0.0625f;
                        }
                    st8(KT + (size_t)(u.pm * 256 + j) * M + tok0 + bj * 128, o1[0], o1[1]);
                    st8(KT + (size_t)(u.pm * 256 + 128 + j) * M + tok0 + bj * 128, o2[0], o2[1]);
                    asm volatile("" ::: "memory");
                }
            }
        }
    }
};
struct EpiGates {
    static constexpr bool PERM = true, AFTER_DRAIN = false; bf16* O;
    __device__ __forceinline__ void operator()(AccRef acc, const Unit& u, int wr_, int wc_, int fr_, int fq_) const {
        EPI_IDX;
        const int row0 = u.pm * 256 + wr * 64 + fr, col0 = u.pn * 256 + wc * 32 + 8 * fq;
#pragma unroll
        for (int ai = 0; ai < 2; ++ai)
#pragma unroll
            for (int m = 0; m < 4; ++m)
#pragma unroll
                for (int bj = 0; bj < 2; ++bj) {
                    f32x4 v0 = acc[ai][bj][m][0], v1 = acc[ai][bj][m][1];
#pragma unroll
                    for (int i = 0; i < 4; ++i) { v0[i] = sigm(v0[i]); v1[i] = sigm(v1[i]); }
                    st8(O + (size_t)(row0 + ai * 128 + m * 16) * 3072 + col0 + bj * 128, v0, v1);
                }
    }
};
struct EpiMix {
    static constexpr bool PERM = true, AFTER_DRAIN = false; const bf16* GATES; float* MIX; bf16* MIXB; int goff, mode;
    __device__ __forceinline__ void operator()(AccRef acc, const Unit& u, int wr_, int wc_, int fr_, int fq_) const {
        EPI_IDX;
        const int row0 = u.pm * 256 + wr * 64 + fr, col0 = u.pn * 256 + wc * 32 + 8 * fq;
#pragma unroll
        for (int ai = 0; ai < 2; ++ai)
#pragma unroll
            for (int m = 0; m < 4; ++m)
#pragma unroll
                for (int bj = 0; bj < 2; ++bj) {
                    const size_t row = (size_t)(row0 + ai * 128 + m * 16); const int col = col0 + bj * 128;
                    const u32x4 gw = *(const u32x4*)(GATES + row * 3072 + goff + col);
                    f32x4 g0 = {bflo(gw.x), bfhi(gw.x), bflo(gw.y), bfhi(gw.y)}, g1 = {bflo(gw.z), bfhi(gw.z), bflo(gw.w), bfhi(gw.w)};
                    f32x4 v0 = acc[ai][bj][m][0] * g0, v1 = acc[ai][bj][m][1] * g1;
                    float* mp = MIX + row * DM + col;
                    if (mode == 1 || mode == 2 || mode == 4) { v0 += *(const f32x4*)mp; v1 += *(const f32x4*)(mp + 4); }
                    if (mode < 2) { *(f32x4*)mp = v0; *(f32x4*)(mp + 4) = v1; }
                    else st8(MIXB + row * DM + col, v0, v1);
                    asm volatile("" ::: "memory");
                }
    }
};

__device__ __forceinline__ void tr_item(const float* W, int K, int N, bf16* WT, int k0, int n0, int drow0, LAS float* scr, int lane) {
    float v[32];
#pragma unroll
    for (int i = 0; i < 32; ++i) { const int kk = 2 * i + (lane >> 5); v[i] = __builtin_nontemporal_load(W + (size_t)(k0 + kk) * N + n0 + (lane & 31)); }
#pragma unroll
    for (int i = 0; i < 32; ++i) { const int kk = 2 * i + (lane >> 5); scr[kk * 33 + (lane & 31)] = v[i]; }
    LDS_WAIT(); asm volatile("" ::: "memory");
    const int c = lane & 7;
#pragma unroll
    for (int j = 0; j < 4; ++j) { const int n = (lane >> 3) + 8 * j; const LAS float* s = scr + (8 * c) * 33 + n;
        u32x4 o; o.x = pk2(s[0 * 33], s[1 * 33]); o.y = pk2(s[2 * 33], s[3 * 33]); o.z = pk2(s[4 * 33], s[5 * 33]); o.w = pk2(s[6 * 33], s[7 * 33]);
        *(u32x4*)(WT + (size_t)(drow0 + n) * K + k0 + 8 * c) = o; }
    LDS_WAIT(); asm volatile("" ::: "memory");
}
__device__ __forceinline__ int maprow(int kind, int n0) {
    if (kind == 0) return n0;
    if (kind == 1) { const int j = n0 < DFF ? n0 : n0 - DFF; return 256 * (j >> 7) + (j & 127) + (n0 < DFF ? 0 : 128); }
    if (n0 < 2048) return n0;
    if (n0 < 3072) return 5120 + (n0 - 2048);
    if (n0 < 4096) return 8192 + (n0 - 3072);
    if (n0 < 6144) return 9216 + (n0 - 4096);
    if (n0 < 8192) return n0;
    if (n0 < 9216) return 2048 + (n0 - 8192);
    if (n0 < 10240) { const int j = n0 - 9216; return 3072 + 256 * (j >> 7) + (j & 127); }
    if (n0 < 11264) { const int j = n0 - 10240; return 3072 + 256 * (j >> 7) + 128 + (j & 127); }
    return n0;
}
__device__ __forceinline__ void prep_matrix(const float* W, int K, int N, bf16* WT, int kind, LAS float* scr, int gw, int NGW, int lane) {
    const int nblk = N / 32, nitems = (K / 64) * nblk;
    for (int it = gw; it < nitems; it += NGW) { const int kb = it / nblk, nb = it % nblk; tr_item(W, K, N, WT, 64 * kb, 32 * nb, maprow(kind, 32 * nb), scr, lane); }
}

__device__ __forceinline__ void norm_phase(const float* Xin, const bf16* H, float coef, const float* post_g, const float* pre_g, float* Xout, bf16* XN, int gw, int NGW, int lane, int dry = 0) {
    for (int row = gw; row < M; row += NGW) {
        f32x4 v[4];
#pragma unroll
        for (int j = 0; j < 4; ++j) v[j] = *((const f32x4*)(Xin + (size_t)row * DM) + lane + 64 * j);
        if (H) {
            f32x4 h[4]; float ss = 0.f;
#pragma unroll
            for (int j = 0; j < 4; ++j) { const u32x2 w = *((const u32x2*)(H + (size_t)row * DM) + lane + 64 * j); h[j] = (f32x4){bflo(w.x), bfhi(w.x), bflo(w.y), bfhi(w.y)};
                ss += (h[j][0] * h[j][0] + h[j][1] * h[j][1]) + (h[j][2] * h[j][2] + h[j][3] * h[j][3]); }
            const float rs = coef * __builtin_amdgcn_rsqf(wave_sum(ss) * (1.f / DM) + EPS);
#pragma unroll
            for (int j = 0; j < 4; ++j) { const f32x4 g = *((const f32x4*)post_g + lane + 64 * j); v[j] += h[j] * rs * g; }
        }
#pragma unroll
        for (int j = 0; j < 4; ++j) if (!dry) *((f32x4*)(Xout + (size_t)row * DM) + lane + 64 * j) = v[j];
        if (pre_g) {
            float ss = 0.f;
#pragma unroll
            for (int j = 0; j < 4; ++j) ss += (v[j][0] * v[j][0] + v[j][1] * v[j][1]) + (v[j][2] * v[j][2] + v[j][3] * v[j][3]);
            const float rs = __builtin_amdgcn_rsqf(wave_sum(ss) * (1.f / DM) + EPS);
#pragma unroll
            for (int j = 0; j < 4; ++j) { const f32x4 g = *((const f32x4*)pre_g + lane + 64 * j); const f32x4 o = v[j] * rs * g;
                u32x2 w; w.x = pk2(o[0], o[1]); w.y = pk2(o[2], o[3]); if (!dry) *((u32x2*)(XN + (size_t)row * DM) + lane + 64 * j) = w; }
        }
    }
}

__device__ __forceinline__ void rope_tables(const int* pos, float* COS, float* SIN, int gtid, int GT) {
    for (int idx = gtid; idx < SEQ * 128; idx += GT) {
        const int t = idx >> 7, j = idx & 127;
        double f = 1.0, r = 0.9305720409296989;
#pragma unroll
        for (int b = 0; b < 7; ++b) { if ((j >> b) & 1) f *= r; r *= r; }
        const double rev = (double)pos[t] * f * 0.15915494309189535;
        const float fr = (float)(rev - __builtin_floor(rev));
        COS[idx] = __builtin_amdgcn_cosf(fr); SIN[idx] = __builtin_amdgcn_sinf(fr);
    }
}

__device__ __forceinline__ void ac_phase(bf16* SB, const bf16* SCSH, const float* cw  , int gtid, int GT, int dry = 0) {
    for (int idx = gtid; idx < M * 128; idx += GT) {
        const int row = idx >> 7, c0 = (idx & 127) * 8, t = row & (SEQ - 1);
        float accv[8];
#pragma unroll
        for (int e = 0; e < 8; ++e) accv[e] = 0.f;
#pragma unroll
        for (int k = 0; k < 3; ++k) {
            if (t - 2 + k >= 0) {
                const u32x4 w = *(const u32x4*)(SCSH + (size_t)(row - 2 + k) * DM + c0);
                const f32x4 w0 = *(const f32x4*)(cw + k * DM + c0), w1 = *(const f32x4*)(cw + k * DM + c0 + 4);
                accv[0] += w0[0] * bflo(w.x); accv[1] += w0[1] * bfhi(w.x); accv[2] += w0[2] * bflo(w.y); accv[3] += w0[3] * bfhi(w.y);
                accv[4] += w1[0] * bflo(w.z); accv[5] += w1[1] * bfhi(w.z); accv[6] += w1[2] * bflo(w.w); accv[7] += w1[3] * bfhi(w.w);
            }
        }
        const u32x4 s = *(const u32x4*)(SB + (size_t)row * DM + c0);
        u32x4 o; o.x = pk2(accv[0] * bflo(s.x), accv[1] * bfhi(s.x)); o.y = pk2(accv[2] * bflo(s.y), accv[3] * bfhi(s.y));
        o.z = pk2(accv[4] * bflo(s.z), accv[5] * bfhi(s.z)); o.w = pk2(accv[6] * bflo(s.w), accv[7] * bfhi(s.w));
        if (!dry) *(u32x4*)(SB + (size_t)row * DM + c0) = o;
    }
}

__device__ __forceinline__ void retnorm_phase(bf16* RET, const float* SS, int gw, int NGW, int lane, int dry = 0) {
    for (int row = gw; row < M; row += NGW) {
        float s = SS[(size_t)row * 64 + lane];
        s += __shfl_xor(s, 1); s += __shfl_xor(s, 2); s += __shfl_xor(s, 4); s += __shfl_xor(s, 8);
        const float rs = __builtin_amdgcn_rsqf(s * (1.f / 512.f) + EPS);
        bf16* p = RET + (size_t)row * 2048 + lane * 32;
#pragma unroll
        for (int j = 0; j < 4; ++j) { u32x4 w = *((u32x4*)p + j);
            w.x = pk2(bflo(w.x) * rs, bfhi(w.x) * rs); w.y = pk2(bflo(w.y) * rs, bfhi(w.y) * rs); w.z = pk2(bflo(w.z) * rs, bfhi(w.z) * rs); w.w = pk2(bflo(w.w) * rs, bfhi(w.w) * rs);
            if (!dry) *((u32x4*)p + j) = w; }
    }
}

#define MFMA16(a, b, c) __builtin_amdgcn_mfma_f32_16x16x32_bf16((a), (b), (c), 0, 0, 0)
template <int D> __device__ __forceinline__ float dpp_shr(float ident, float x) {
    return __builtin_bit_cast(float, __builtin_amdgcn_update_dpp(__builtin_bit_cast(int, ident), __builtin_bit_cast(int, x), 0x110 + D, 0xf, 0xf, false));
}
constexpr int LRU_TILE = 67 * 144;
template <bool FINAL>
__device__ __forceinline__ void lru_phase(LAS unsigned char* ldsw  , const bf16* XA, bf16* YA, const float* convw, const float* convb, const bf16* WaT, const bf16* WxT,
                                          const float* ba, const float* bx, const float* lam, float* AGGA, float* AGGH, int gw, int NGW, int lane, int dry = 0) {
    const int r = lane & 15, q = lane >> 4;
    for (int item = gw; item < NB * 32 * 16; item += NGW) {
        const int g = item & 15, s = (item >> 4) & 31, b = item >> 9;
        const size_t rowb = (size_t)b * SEQ;
        {
            u32x4 pc[9];
#pragma unroll
            for (int j = 0; j < 9; ++j) { const int p = lane + 64 * j, row = p >> 3, c16 = p & 7, t = 64 * s - 3 + row;
                pc[j] = (u32x4){0u, 0u, 0u, 0u};
                if (p < 536 && t >= 0) pc[j] = *(const u32x4*)(XA + (rowb + t) * DM + 64 * g + 8 * c16); }
#pragma unroll
            for (int j = 0; j < 9; ++j) { const int p = lane + 64 * j, row = p >> 3, c16 = p & 7; if (p < 536) *(LAS u32x4*)(ldsw + row * 144 + c16 * 16) = pc[j]; }
        }
        bf16x8 xf[4][2];
#pragma unroll
        for (int ks = 0; ks < 2; ++ks) {
            const int c0 = 64 * g + 32 * ks + 8 * q;
            f32x4 w0[4], w1[4];
#pragma unroll
            for (int k = 0; k < 4; ++k) { w0[k] = *(const f32x4*)(convw + k * DM + c0); w1[k] = *(const f32x4*)(convw + k * DM + c0 + 4); }
            const f32x4 b0 = *(const f32x4*)(convb + c0), b1 = *(const f32x4*)(convb + c0 + 4);
#pragma unroll
            for (int tt = 0; tt < 4; ++tt) {
                f32x4 x0 = b0, x1 = b1;
#pragma unroll
                for (int k = 0; k < 4; ++k) { const u32x4 w = *(const LAS u32x4*)(ldsw + (16 * tt + r + k) * 144 + (32 * ks + 8 * q) * 2);
                    x0 += w0[k] * (f32x4){bflo(w.x), bfhi(w.x), bflo(w.y), bfhi(w.y)}; x1 += w1[k] * (f32x4){bflo(w.z), bfhi(w.z), bflo(w.w), bfhi(w.w)}; }
                u32x4 p; p.x = pk2(x0[0], x0[1]); p.y = pk2(x0[2], x0[3]); p.z = pk2(x1[0], x1[1]); p.w = pk2(x1[2], x1[3]);
                xf[tt][ks] = __builtin_bit_cast(bf16x8, p);
            }
        }
#pragma unroll 1
        for (int ct = 0; ct < 4; ++ct) {
            bf16x8 af[2], xw[2];
#pragma unroll
            for (int ks = 0; ks < 2; ++ks) { af[ks] = *(const bf16x8*)(WaT + g * 4096 + (16 * ct + r) * 64 + 32 * ks + 8 * q); xw[ks] = *(const bf16x8*)(WxT + g * 4096 + (16 * ct + r) * 64 + 32 * ks + 8 * q); }
            f32x4 aR[4], aI[4];
#pragma unroll
            for (int tt = 0; tt < 4; ++tt) { aR[tt] = (f32x4){0.f, 0.f, 0.f, 0.f}; aI[tt] = (f32x4){0.f, 0.f, 0.f, 0.f};
#pragma unroll
                for (int ks = 0; ks < 2; ++ks) { aR[tt] = MFMA16(af[ks], xf[tt][ks], aR[tt]); aI[tt] = MFMA16(xw[ks], xf[tt][ks], aI[tt]); } }
            const int ch0 = 64 * g + 16 * ct + 4 * q;
            const f32x4 ba4 = *(const f32x4*)(ba + ch0), bx4 = *(const f32x4*)(bx + ch0), lam4 = *(const f32x4*)(lam + ch0), cb = *(const f32x4*)(convb + ch0);
            f32x4 cw[4], sp4;
#pragma unroll
            for (int k = 0; k < 4; ++k) cw[k] = *(const f32x4*)(convw + k * DM + ch0);
#pragma unroll
            for (int jj = 0; jj < 4; ++jj) { const float z = -lam4[jj]; sp4[jj] = -11.541560327111707f * ((z > 0.f ? z : 0.f) + log1pf(__expf(-fabsf(z)))); }
            f32x4 Ain = {1.f, 1.f, 1.f, 1.f}, Hin = {0.f, 0.f, 0.f, 0.f};
            if (FINAL) {
                for (int sp = 0; sp < s; ++sp) { const f32x4 a4 = *(const f32x4*)(AGGA + (size_t)(b * 32 + sp) * DM + ch0), h4 = *(const f32x4*)(AGGH + (size_t)(b * 32 + sp) * DM + ch0); Hin = a4 * Hin + h4; }
            }
            u32x2 yv[4];
            if (FINAL) {
#pragma unroll
                for (int tt = 0; tt < 4; ++tt) yv[tt] = *(const u32x2*)(YA + (rowb + 64 * s + 16 * tt + r) * DM + ch0);
            }
#pragma unroll
            for (int tt = 0; tt < 4; ++tt) {
                f32x4 xp = cb;
#pragma unroll
                for (int k = 0; k < 4; ++k) { const u32x2 w = *(const LAS u32x2*)(ldsw + (16 * tt + r + k) * 144 + (16 * ct + 4 * q) * 2); xp += cw[k] * (f32x4){bflo(w.x), bfhi(w.x), bflo(w.y), bfhi(w.y)}; }
                f32x4 av, uv;
#pragma unroll
                for (int jj = 0; jj < 4; ++jj) {
                    const float rr = sigm(aR[tt][jj] + ba4[jj]), ii = sigm(aI[tt][jj] + bx4[jj]);
                    const float a = __builtin_amdgcn_exp2f(rr * sp4[jj]);
                    av[jj] = a; uv[jj] = __builtin_amdgcn_sqrtf(__builtin_fmaf(-a, a, 1.0f)) * ii * xp[jj];
                }
#pragma unroll
                for (int jj = 0; jj < 4; ++jj) {
                    float a = av[jj], u = uv[jj], ap, up;
                    ap = dpp_shr<1>(1.0f, a); up = dpp_shr<1>(0.0f, u); u = a * up + u; a = a * ap;
                    ap = dpp_shr<2>(1.0f, a); up = dpp_shr<2>(0.0f, u); u = a * up + u; a = a * ap;
                    ap = dpp_shr<4>(1.0f, a); up = dpp_shr<4>(0.0f, u); u = a * up + u; a = a * ap;
                    ap = dpp_shr<8>(1.0f, a); up = dpp_shr<8>(0.0f, u); u = a * up + u; a = a * ap;
                    av[jj] = a; uv[jj] = u;
                }
                const f32x4 hv = uv + av * Hin;
                if (FINAL) {
                    const u32x2 w = yv[tt];
                    u32x2 o; o.x = pk2(hv[0] * bflo(w.x), hv[1] * bfhi(w.x)); o.y = pk2(hv[2] * bflo(w.y), hv[3] * bfhi(w.y));
                    if (!dry) *(u32x2*)(YA + (rowb + 64 * s + 16 * tt + r) * DM + ch0) = o;
                }
#pragma unroll
                for (int jj = 0; jj < 4; ++jj) { Hin[jj] = __shfl(hv[jj], 15, 16); if (!FINAL) Ain[jj] *= __shfl(av[jj], 15, 16); }
            }
            if (!FINAL && r == 0) { *(f32x4*)(AGGA + (size_t)(b * 32 + s) * DM + ch0) = Ain; *(f32x4*)(AGGH + (size_t)(b * 32 + s) * DM + ch0) = Hin; }
        }
    }
}

constexpr int R_KS = 0, R_ST = 33792, R_VT = 67584, R_VP = 76800, R_P = 95232, R_Q = 104448;
__device__ __forceinline__ void retention_phase(LAS unsigned char* lds, const bf16* Q, const bf16* K, const bf16* KT, const bf16* VT, bf16* G, float* SS, int bid, int nblk, int tid, int dry = 0) {
    const int w = __builtin_amdgcn_readfirstlane(tid >> 6), lane = tid & 63, r = lane & 15, q = lane >> 4, it = w & 3, hh = w >> 2;
    for (int item = bid; item < 256; item += nblk) {
        const int xcd = item & 7, loc = item >> 3, pair = xcd * 4 + (loc >> 3), slice = loc & 7, b = pair >> 2, h = pair & 3;
        const float log2g = __builtin_amdgcn_logf(1.0f - __builtin_amdgcn_exp2f(-5.0f - (float)h));
        const float cd = __builtin_amdgcn_exp2f(log2g * 64.0f);
        for (int i = tid; i < 33792 / 16; i += NTHREADS) *(LAS u32x4*)(lds + R_ST + i * 16) = (u32x4){0u, 0u, 0u, 0u};
        f32x4 st[2][4];
#pragma unroll
        for (int a = 0; a < 2; ++a)
#pragma unroll
            for (int e = 0; e < 4; ++e) st[a][e] = (f32x4){0.f, 0.f, 0.f, 0.f};
        __syncthreads();
        const int ve = tid >> 3, vc = tid & 7;
        u32x4 kreg[4], qreg[4], vreg;
        unsigned kqo[4], kto[2][2], go[2]; const unsigned vto = (unsigned)(ve * M + vc * 8) * 2u;
#pragma unroll
        for (int i = 0; i < 4; ++i) { const int p = tid + NTHREADS * i, row = p >> 5, c16 = p & 31; kqo[i] = (unsigned)(row * DM + c16 * 8) * 2u; }
#pragma unroll
        for (int dl = 0; dl < 2; ++dl)
#pragma unroll
            for (int ks = 0; ks < 2; ++ks) kto[dl][ks] = (unsigned)((32 * w + 16 * dl + r) * M + 32 * ks + 8 * q) * 2u;
#pragma unroll
        for (int el = 0; el < 2; ++el) go[el] = (unsigned)((16 * it + r) * 2048 + 16 * (2 * hh + el) + 4 * q) * 2u;
#define RET_LOADS(nn) do { const size_t rb_ = (size_t)b * SEQ + (nn) * 64; \
            const char* kb_ = (const char*)K + (rb_ * DM + h * 256) * 2; const char* qb_ = (const char*)Q + (rb_ * DM + h * 256) * 2; const char* vb_ = (const char*)VT + ((size_t)(h * 512 + slice * 64) * M + rb_) * 2; \
            _Pragma("unroll") for (int i = 0; i < 4; ++i) { kreg[i] = *(const u32x4*)(kb_ + kqo[i]); qreg[i] = *(const u32x4*)(qb_ + kqo[i]); } \
            vreg = *(const u32x4*)(vb_ + vto); } while (0)
#define RET_LOADS_CUR(nn) do { const size_t rb_ = (size_t)b * SEQ + (nn) * 64; \
            const char* gb_ = (const char*)G + (rb_ * 2048 + h * 512 + slice * 64) * 2; const char* tb_ = (const char*)KT + ((size_t)(h * 256) * M + rb_) * 2; \
            _Pragma("unroll") for (int el = 0; el < 2; ++el) gv[el] = *(const u32x2*)(gb_ + go[el]); \
            _Pragma("unroll") for (int dl = 0; dl < 2; ++dl) _Pragma("unroll") for (int ks = 0; ks < 2; ++ks) ktf[dl][ks] = *(const bf16x8*)(tb_ + kto[dl][ks]); } while (0)
        RET_LOADS(0);
#pragma unroll 1
        for (int n = 0; n < 32; ++n) {
            const size_t rowbase = (size_t)b * SEQ + n * 64;
            int zl = 0; asm volatile("" : "+v"(zl));
            const int tid_ = tid + zl, ve_ = ve + zl, vc_ = vc + zl, r_ = r + zl, q_ = q + zl;
            bf16x8 ktf[2][2]; u32x2 gv[2];
            RET_LOADS_CUR(n); __builtin_amdgcn_sched_barrier(0);
#pragma unroll
            for (int i = 0; i < 4; ++i) { const int p = tid_ + NTHREADS * i, row = p >> 5, c16 = p & 31; *(LAS u32x4*)(lds + R_KS + row * 528 + c16 * 16) = kreg[i]; *(LAS u32x4*)(lds + R_Q + row * 528 + c16 * 16) = qreg[i]; }
            *(LAS u32x4*)(lds + R_VT + ve_ * 144 + vc_ * 16) = vreg;
            {
                float kd[8];
#pragma unroll
                for (int e = 0; e < 8; ++e) kd[e] = __builtin_amdgcn_exp2f(log2g * (float)(63 - (vc_ * 8 + e)));
                u32x4 o; o.x = pk2(bflo(vreg.x) * kd[0], bfhi(vreg.x) * kd[1]); o.y = pk2(bflo(vreg.y) * kd[2], bfhi(vreg.y) * kd[3]);
                o.z = pk2(bflo(vreg.z) * kd[4], bfhi(vreg.z) * kd[5]); o.w = pk2(bflo(vreg.w) * kd[6], bfhi(vreg.w) * kd[7]);
                *(LAS u32x4*)(lds + R_VP + (n & 1) * 9216 + ve_ * 144 + vc_ * 16) = o;
            }
            __builtin_amdgcn_sched_barrier(0);
            if (n + 1 < 32) RET_LOADS(n + 1);
            __builtin_amdgcn_sched_barrier(0);
            __syncthreads(); __builtin_amdgcn_sched_barrier(0);
            {
            bf16x8 qf[8];
#pragma unroll
            for (int ks = 0; ks < 8; ++ks) qf[ks] = *(const LAS bf16x8*)(lds + R_Q + (16 * it + r_) * 528 + (32 * ks + 8 * q_) * 2);
#pragma unroll
            for (int jl = 0; jl < 2; ++jl) {
                const int jt = 2 * hh + jl; f32x4 acc = {0.f, 0.f, 0.f, 0.f};
#pragma unroll
                for (int ks = 0; ks < 8; ++ks) { const bf16x8 kf = *(const LAS bf16x8*)(lds + R_KS + (16 * jt + r_) * 528 + (32 * ks + 8 * q_) * 2); acc = MFMA16(kf, qf[ks], acc); }
                const int i_ = 16 * it + r_, j0 = 16 * jt + 4 * q_;
                float p[4];
#pragma unroll
                for (int jj = 0; jj < 4; ++jj) { const int dd = i_ - (j0 + jj); p[jj] = acc[jj] * __builtin_amdgcn_exp2f(log2g * (float)(dd < 0 ? -dd : dd)); }
                u32x2 o; o.x = pk2(p[0], p[1]); o.y = pk2(p[2], p[3]);
                *(LAS u32x2*)(lds + R_P + i_ * 144 + j0 * 2) = o;
            }
            }
            __builtin_amdgcn_sched_barrier(0);
            __syncthreads(); __builtin_amdgcn_sched_barrier(0);
            {
                const float qd = __builtin_amdgcn_exp2f(log2g * (float)(16 * it + r_ + 1));
                float ss = 0.f;
                bf16x8 qf[8];
#pragma unroll
                for (int ks = 0; ks < 8; ++ks) qf[ks] = *(const LAS bf16x8*)(lds + R_Q + (16 * it + r_) * 528 + (32 * ks + 8 * q_) * 2);
#pragma unroll
                for (int el = 0; el < 2; ++el) {
                    const int et = 2 * hh + el; f32x4 acc = {0.f, 0.f, 0.f, 0.f};
#pragma unroll
                    for (int ks = 0; ks < 8; ++ks) { const bf16x8 sf = *(const LAS bf16x8*)(lds + R_ST + (16 * et + r_) * 528 + (32 * ks + 8 * q_) * 2); acc = MFMA16(sf, qf[ks], acc); }
                    acc = acc * qd;
#pragma unroll
                    for (int ks = 0; ks < 2; ++ks) { const bf16x8 vf = *(const LAS bf16x8*)(lds + R_VT + (16 * et + r_) * 144 + (32 * ks + 8 * q_) * 2);
                        const bf16x8 pf = *(const LAS bf16x8*)(lds + R_P + (16 * it + r_) * 144 + (32 * ks + 8 * q_) * 2); acc = MFMA16(vf, pf, acc); }
                    ss += (acc[0] * acc[0] + acc[1] * acc[1]) + (acc[2] * acc[2] + acc[3] * acc[3]);
                    char* gp = (char*)G + (rowbase * 2048 + h * 512 + slice * 64) * 2 + go[el];
                    u32x2 o; o.x = pk2(acc[0] * bflo(gv[el].x), acc[1] * bfhi(gv[el].x)); o.y = pk2(acc[2] * bflo(gv[el].y), acc[3] * bfhi(gv[el].y));
                    if (!dry) *(u32x2*)gp = o;
                }
                ss += __shfl_xor(ss, 16); ss += __shfl_xor(ss, 32);
                if (q_ == 0 && !dry) SS[((rowbase + 16 * it + r_) * 4 + h) * 16 + slice * 2 + hh] = ss;
            }
            __builtin_amdgcn_sched_barrier(0);
            __syncthreads(); __builtin_amdgcn_sched_barrier(0);
#pragma unroll
            for (int dl = 0; dl < 2; ++dl)
#pragma unroll
                for (int et = 0; et < 4; ++et) {
                    f32x4 a = st[dl][et] * cd;
#pragma unroll
                    for (int ks = 0; ks < 2; ++ks) { const bf16x8 vp = *(const LAS bf16x8*)(lds + R_VP + (n & 1) * 9216 + (16 * et + r_) * 144 + (32 * ks + 8 * q_) * 2); a = MFMA16(ktf[dl][ks], vp, a); }
                    st[dl][et] = a;
                    u32x2 o; o.x = pk2(a[0], a[1]); o.y = pk2(a[2], a[3]);
                    *(LAS u32x2*)(lds + R_ST + (16 * et + r_) * 528 + (32 * w + 16 * dl + 4 * q_) * 2) = o;
                }
        }
        __syncthreads();
    }
}


#define PH_IDX int tid = threadIdx.x; asm volatile("" : "+v"(tid)); const int lane = tid & 63, wave = __builtin_amdgcn_readfirstlane(tid >> 6), gw = bid * NWAVES + wave, gtid = bid * NTHREADS + tid; \
        LAS float* scr = (LAS float*)(lds + wave * 16384); (void)lane; (void)gw; (void)gtid; (void)scr
#define WSP(T, off) ((T*)(wsb + (off)))
#define MBP(T, off) ((T*)(wsb + WS_MB + (off)))
#define IN_L(idx, l, n) (rd_ptr(ptab, idx) + (size_t)(l) * (n))
#define PREP_FFN(widx_in, widx_out, l) do { prep_matrix(IN_L(widx_in, l, (size_t)DM * 2 * DFF), DM, 2 * DFF, WSP(bf16, WS_WF), 1, scr, gw, NGW, lane); \
        prep_matrix(IN_L(widx_out, l, (size_t)DFF * DM), DFF, DM, WSP(bf16, WS_WF) + (size_t)2 * DFF * DM, 0, scr, gw, NGW, lane); } while (0)
#define WM_IN_  WSP(bf16, WS_WM)
#define WM_LRU_ (WM_IN_ + (size_t)MIXIN * DM)
#define WM_SC_  (WM_LRU_ + (size_t)DM * DM)
#define WM_RET_ (WM_SC_ + (size_t)DM * DM)
#define WM_OUT_ (WM_RET_ + (size_t)2048 * DM)
#define WAT_ WSP(bf16, WS_LRUW)
#define WXT_ (WSP(bf16, WS_LRUW) + 16 * 64 * 64)
#define PREP_MIX(l) do { prep_matrix(IN_L(7, l, (size_t)DM * MIXIN), DM, MIXIN, WM_IN_, 2, scr, gw, NGW, lane); \
        prep_matrix(IN_L(15, l, (size_t)DM * DM), DM, DM, WM_LRU_, 0, scr, gw, NGW, lane); prep_matrix(IN_L(18, l, (size_t)DM * DM), DM, DM, WM_SC_, 0, scr, gw, NGW, lane); \
        prep_matrix(IN_L(16, l, (size_t)2048 * DM), 2048, DM, WM_RET_, 0, scr, gw, NGW, lane); prep_matrix(IN_L(19, l, (size_t)DM * DM), DM, DM, WM_OUT_, 0, scr, gw, NGW, lane); \
        for (int g_ = 0; g_ < 16; ++g_) { prep_matrix(IN_L(10, l, 65536) + g_ * 4096, 64, 64, WAT_ + g_ * 4096, 0, scr, gw, NGW, lane); prep_matrix(IN_L(12, l, 65536) + g_ * 4096, 64, 64, WXT_ + g_ * 4096, 0, scr, gw, NGW, lane); } } while (0)
#define COS_ WSP(float, WS_ROPE)
#define SIN_ (WSP(float, WS_ROPE) + SEQ * 128)
#define AGGA_ WSP(float, WS_AGG)
#define AGGH_ (WSP(float, WS_AGG) + NB * 32 * DM)


#if defined(CHECK)
__device__ __forceinline__ float bfa(const bf16* p, size_t i) { return __builtin_bit_cast(float, (unsigned)p[i] << 16); }
__device__ __forceinline__ float dotx(const bf16* XN, size_t row, const bf16* W, size_t wrow) { float a = 0.f; for (int k = 0; k < DM; ++k) a += bfa(XN, row * DM + k) * bfa(W, wrow * DM + k); return a; }
__device__ __forceinline__ bool badv(float got, float e, float rel, float ab) { return !(fabsf(got - e) <= rel * fabsf(e) + ab); }
__device__ __forceinline__ void flag(float* DB, int s, float w) { if (DB[s] < w) DB[s] = w; }
struct ChkP { LAS const unsigned long long* pt; unsigned char* wsb; float* DB; };
#define CK_ROW(s) (((s) * 37 + ((s) >> 14) * 4099 + ((s) >> 4) * 263) & (M - 1))
#define CK_H1(s) ((unsigned)(s) * 2654435761u >> 7)
__device__ __forceinline__ void chk_stage(const ChkP& P, int stage, int s) {
    unsigned char* wsb = P.wsb; float* DB = P.DB;
    const bf16* XN = WSP(bf16, WS_XN); const bf16* W = WM_IN_;
    const size_t row = CK_ROW(s); const unsigned hh = CK_H1(s); const int c = hh & 1023; const int t = (int)(row & (SEQ - 1)); const size_t rowb = row - t;
    if (stage == 0) {
        const int n = hh % MIXIN, k = (hh >> 5) & 1023;
        if (bfa(W, (size_t)(maprow(2, n & ~31) + (n & 31)) * DM + k) != __builtin_bit_cast(float, f2bf(rd_ptr(P.pt, 7)[(size_t)k * MIXIN + n]) << 16)) flag(DB, s, 1e13f);
        const int j2 = (hh >> 3) & 2047;
        if (bfa(WM_RET_, (size_t)c * 2048 + j2) != __builtin_bit_cast(float, f2bf(rd_ptr(P.pt, 16)[(size_t)j2 * DM + c]) << 16)) flag(DB, s, 1e13f);
        const int j1 = j2 & 1023;
        if (bfa(WM_LRU_, (size_t)c * DM + j1) != __builtin_bit_cast(float, f2bf(rd_ptr(P.pt, 15)[(size_t)j1 * DM + c]) << 16)) flag(DB, s, 1e13f);
        if (bfa(WM_SC_, (size_t)c * DM + j1) != __builtin_bit_cast(float, f2bf(rd_ptr(P.pt, 18)[(size_t)j1 * DM + c]) << 16)) flag(DB, s, 1e13f);
        if (bfa(WM_OUT_, (size_t)c * DM + j1) != __builtin_bit_cast(float, f2bf(rd_ptr(P.pt, 19)[(size_t)j1 * DM + c]) << 16)) flag(DB, s, 1e13f);
        const int g = c >> 6, jo = c & 63, ii = j1 & 63;
        if (bfa(WAT_, (size_t)g * 4096 + jo * 64 + ii) != __builtin_bit_cast(float, f2bf(rd_ptr(P.pt, 10)[(size_t)g * 4096 + ii * 64 + jo]) << 16)) flag(DB, s, 1e13f);
        if (bfa(WXT_, (size_t)g * 4096 + jo * 64 + ii) != __builtin_bit_cast(float, f2bf(rd_ptr(P.pt, 12)[(size_t)g * 4096 + ii * 64 + jo]) << 16)) flag(DB, s, 1e13f);
        const int j = c & 127; double f = 1.0, r = 0.9305720409296989; for (int b = 0; b < 7; ++b) { if ((j >> b) & 1) f *= r; r *= r; }
        double ang = (double)((const int*)rd_ptr(P.pt, 1))[t] * f; ang -= 6.283185307179586 * __builtin_floor(ang * 0.15915494309189535 + 0.5);
        double cs = 1.0, sn = ang, term = 1.0, a2 = ang * ang; term = 1.0; double tc = 1.0, ts = ang;
        for (int n2 = 1; n2 < 14; ++n2) { tc *= -a2 / ((2.0 * n2 - 1.0) * (2.0 * n2)); cs += tc; ts *= -a2 / ((2.0 * n2) * (2.0 * n2 + 1.0)); sn += ts; }
        (void)term;
        if (badv(COS_[t * 128 + j], (float)cs, 0.f, 2e-5f) || badv(SIN_[t * 128 + j], (float)sn, 0.f, 2e-5f)) flag(DB, s, 1e13f);
    } else if (stage == 1) {
        if (badv(bfa(MBP(bf16, MB_XA), row * DM + c), dotx(XN, row, W, c), 0.02f, 0.02f)) flag(DB, s, 1e12f);
        if (badv(bfa(MBP(bf16, MB_YA), row * DM + c), gelu_t(dotx(XN, row, W, 1024 + c)), 0.02f, 0.02f)) flag(DB, s, 1e12f);
        if (badv(bfa(MBP(bf16, MB_SB), row * DM + c), dotx(XN, row, W, 2048 + c), 0.02f, 0.02f)) flag(DB, s, 1e12f);
        { const size_t d0 = 3072 + 256 * (c >> 7) + (c & 127); if (badv(bfa(MBP(bf16, MB_SCSH), row * DM + c), dotx(XN, row, W, d0) * dotx(XN, row, W, d0 + 128), 0.03f, 0.03f)) flag(DB, s, 1e12f); }
        { const int h = c >> 8, d = c & 255, j = d & 127; const float cs = COS_[t * 128 + j], sn = SIN_[t * 128 + j];
          float q1 = dotx(XN, row, W, 5120 + h * 256 + j), q2 = dotx(XN, row, W, 5120 + h * 256 + 128 + j);
          if (badv(bfa(MBP(bf16, MB_Q), row * DM + c), d < 128 ? q1 * cs - q2 * sn : q1 * sn + q2 * cs, 0.02f, 0.03f)) flag(DB, s, 1e11f);
          q1 = dotx(XN, row, W, 8192 + h * 256 + j); q2 = dotx(XN, row, W, 8192 + h * 256 + 128 + j);
          const float ke = (d < 128 ? q1 * cs - q2 * sn : q1 * sn + q2 * cs) * 0.0625f;
          if (badv(bfa(MBP(bf16, MB_K), row * DM + c), ke, 0.02f, 0.003f)) flag(DB, s, 1e11f);
          if (badv(bfa(MBP(bf16, MB_KT), (size_t)c * M + row), ke, 0.02f, 0.003f)) flag(DB, s, 1e10f); }
        { const int cv = hh & 2047; if (badv(bfa(MBP(bf16, MB_G), row * 2048 + cv), silu_f(dotx(XN, row, W, 6144 + cv)), 0.02f, 0.02f)) flag(DB, s, 1e11f);
          if (badv(bfa(MBP(bf16, MB_VT), (size_t)cv * M + row), dotx(XN, row, W, 9216 + cv), 0.02f, 0.02f)) flag(DB, s, 1e10f); }
    } else if (stage == 2) {
        const int h = (s >> 8) & 3, e = hh & 511, n = t >> 6; const float gam = 1.0f - exp2f(-5.0f - (float)h);
        const bf16 *Q = MBP(bf16, MB_Q), *K = MBP(bf16, MB_K), *VT = MBP(bf16, MB_VT);
        if ((s & 15) == 0) {
            float acc = 0.f;
            for (int si = 0; si < (n + 1) * 64; ++si) { float d = 0.f; for (int x = 0; x < 256; ++x) d += bfa(Q, row * DM + h * 256 + x) * bfa(K, (rowb + si) * DM + h * 256 + x);
                const int dist = (si >> 6) == n ? (t > si ? t - si : si - t) : t - si; acc += powf(gam, (float)dist) * d * bfa(VT, (size_t)(h * 512 + e) * M + rowb + si); }
            const float sg = silu_f(dotx(XN, row, W, 6144 + h * 512 + e)); const float ex = acc * sg;
            float ssum = 0.f; for (int i = 0; i < 16; ++i) ssum += WSP(float, WS_SS)[(row * 4 + h) * 16 + i];
            const float rms = sqrtf(ssum / 512.f);
            float r5 = 0.05f, r3 = 0.03f; asm volatile("" : "+v"(r5), "+v"(r3));
            if (badv(bfa(MBP(bf16, MB_G), row * 2048 + h * 512 + e), ex, r5, r3 * rms * fabsf(sg) + 0.01f)) flag(DB, s, 1e9f);
        }
        { const float* cw = rd_ptr(P.pt, 17); float a = 0.f; for (int k = 0; k < 3; ++k) if (t - 2 + k >= 0) a += cw[k * DM + c] * bfa(MBP(bf16, MB_SCSH), (row - 2 + k) * DM + c);
          if (badv(bfa(MBP(bf16, MB_SB), row * DM + c), a * dotx(XN, row, W, 2048 + c), 0.03f, 0.03f)) flag(DB, s, 1e8f); }
    } else if (stage == 3) {
        if ((s & 15) == 1) {
            const int g = c >> 6, jo = c & 63; const bf16* XA = MBP(bf16, MB_XA);
            const float *cw = rd_ptr(P.pt, 8), *cb = rd_ptr(P.pt, 9), *wa = rd_ptr(P.pt, 10) + g * 4096, *wx = rd_ptr(P.pt, 12) + g * 4096;
            const float lam = rd_ptr(P.pt, 14)[c], sp = (-lam > 0.f ? -lam : 0.f) + log1pf(expf(-fabsf(lam)));
            float hst = 0.f;
            for (int si = 0; si <= t; ++si) {
                float rr = rd_ptr(P.pt, 11)[c], iv = rd_ptr(P.pt, 13)[c], xc = 0.f;
                for (int ci = 0; ci < 64; ++ci) { const int ch = g * 64 + ci; float xp = cb[ch];
                    for (int k = 0; k < 4; ++k) if (si - 3 + k >= 0) xp += cw[k * DM + ch] * bfa(XA, (rowb + si - 3 + k) * DM + ch);
                    rr += xp * wa[ci * 64 + jo]; iv += xp * wx[ci * 64 + jo]; if (ci == jo) xc = xp; }
                const float la = -8.0f * sigm(rr) * sp, a = expf(la); hst = a * hst + sqrtf(-expm1f(2.0f * la)) * sigm(iv) * xc;
            }
            if (badv(bfa(MBP(bf16, MB_YA), row * DM + c), hst * gelu_t(dotx(XN, row, W, 1024 + c)), 0.05f, 0.02f)) flag(DB, s, 1e7f);
        }
        { const int cg = hh % 3072; if (badv(bfa(MBP(bf16, MB_GATES), row * 3072 + cg), sigm(dotx(XN, row, W, 11264 + cg)), 0.02f, 0.01f)) flag(DB, s, 1e6f); }
        if ((s & 255) == 2) {
            const int h = (s >> 8) & 3; float sq = 0.f; int cnt = 0;
            for (int e = 0; e < 512; ++e) { const float gv = silu_f(dotx(XN, row, W, 6144 + h * 512 + e)); if (fabsf(gv) > 0.1f) { const float o = bfa(MBP(bf16, MB_G), row * 2048 + h * 512 + e) / gv; sq += o * o; ++cnt; } }
            if (cnt > 50 && badv(sq / cnt, 1.0f, 0.35f, 0.f)) flag(DB, s, 1e5f);
        }
    } else if (stage == 4) {
        float oa = 0.f, oc = 0.f, ob = 0.f;
        for (int j = 0; j < DM; ++j) { oa += bfa(MBP(bf16, MB_YA), row * DM + j) * bfa(WM_LRU_, (size_t)c * DM + j); oc += bfa(MBP(bf16, MB_SB), row * DM + j) * bfa(WM_SC_, (size_t)c * DM + j); }
        for (int j = 0; j < 2048; ++j) ob += bfa(MBP(bf16, MB_G), row * 2048 + j) * bfa(WM_RET_, (size_t)c * 2048 + j);
        const bf16* GT_ = MBP(bf16, MB_GATES);
        const float ex = bfa(GT_, row * 3072 + c) * oa + bfa(GT_, row * 3072 + 1024 + c) * ob + bfa(GT_, row * 3072 + 2048 + c) * oc;
        if (badv(bfa(MBP(bf16, MB_MIXB), row * DM + c), ex, 0.02f, 0.02f)) flag(DB, s, 1e4f);
    } else if (stage == 5) {
        float h = 0.f; for (int j = 0; j < DM; ++j) h += bfa(MBP(bf16, MB_MIXB), row * DM + j) * bfa(WM_OUT_, (size_t)c * DM + j);
        if (badv(bfa(MBP(bf16, MB_H), row * DM + c), h, 0.02f, 0.02f)) flag(DB, s, 1e3f);
    }
}
#endif
#define XB_TMO      128
#define XB_XCNT(j)  (256  + 64 * (j))
#define XB_XSUB(j)  (1280 + 64 * (j))
#define XB_XGEN(j)  (2304 + 64 * (j))
#define XB_TOP      3328
#define XB_TOPGEN   3392
#define XCD_BAR_WORDS 3456
#define XB_SPIN_CAP (1u << 18)

__device__ __forceinline__ unsigned xb_ld(unsigned* p)              { return __hip_atomic_load(p, __ATOMIC_RELAXED, __HIP_MEMORY_SCOPE_AGENT); }
__device__ __forceinline__ unsigned xb_add(unsigned* p, unsigned v) { return __hip_atomic_fetch_add(p, v, __ATOMIC_RELAXED, __HIP_MEMORY_SCOPE_AGENT); }
__device__ __forceinline__ unsigned xb_xcc_id() { return (unsigned)__builtin_amdgcn_s_getreg((3 << 11) | 20) & 0xFu; }
#define XB_SPIN(cond, bar) do { unsigned _sp = 0; while (cond) { __builtin_amdgcn_s_sleep(1); \
    if ((++_sp & 255u) == 0u) { if (xb_ld(&(bar)[XB_TMO])) break; if (_sp > XB_SPIN_CAP) { atomicAdd(&(bar)[XB_TMO], 1u); break; } } } } while (0)

struct XcdBarrier {
    unsigned* bar; unsigned x;
    volatile LAS unsigned* st;
};

__device__ __forceinline__ XcdBarrier xcd_barrier_post(unsigned* bar, volatile LAS unsigned* st) {
    XcdBarrier b; b.bar = bar; b.x = xb_xcc_id(); b.st = st;
    if (threadIdx.x == 0) (void)xb_add(&bar[XB_XCNT(b.x)], 1u);
    return b;
}
__device__ __forceinline__ void xcd_barrier_complete(unsigned* bar, unsigned x, unsigned& nloc, unsigned& nx) {
    const unsigned G = gridDim.x * gridDim.y * gridDim.z;
    unsigned sum, cnt, mine, sp = 0u;
    for (;;) {
        sum = 0u; cnt = 0u; mine = 0u;
#pragma unroll
        for (unsigned j = 0; j < 16; ++j) { const unsigned c = xb_ld(&bar[XB_XCNT(j)]); sum += c; cnt += (c > 0u) ? 1u : 0u; mine = (j == x) ? c : mine; }
        if (sum == G) break;
        __builtin_amdgcn_s_sleep(1);
        if ((++sp & 255u) == 0u) { if (xb_ld(&bar[XB_TMO])) break; if (sp > XB_SPIN_CAP) { atomicAdd(&bar[XB_TMO], 1u); break; } }
    }
    nloc = mine > 0u ? mine : 1u; nx = cnt > 0u ? cnt : 1u;
}

__device__ __forceinline__ void xcd_barrier(const XcdBarrier& b) {
    asm volatile("s_waitcnt vmcnt(0)" ::: "memory");
    __syncthreads();
    if (threadIdx.x == 0) {
        unsigned* bar = b.bar;
        __builtin_amdgcn_s_waitcnt(0);
        unsigned nloc = b.st[0], nx = b.st[1];
        if (nloc == 0u) { xcd_barrier_complete(bar, b.x, nloc, nx); b.st[0] = nloc; b.st[1] = nx; }
        const unsigned old = xb_add(&bar[XB_XSUB(b.x)], 1u);
        const unsigned gen = old / nloc;
        if (old + 1u == (gen + 1u) * nloc) {
            __builtin_amdgcn_fence(__ATOMIC_RELEASE, "agent");
            asm volatile("s_waitcnt vmcnt(0)" ::: "memory");
            const unsigned og = xb_add(&bar[XB_TOP], 1u);
            const unsigned tg = og / nx;
            if (og + 1u == (tg + 1u) * nx) xb_add(&bar[XB_TOPGEN], 1u);
            else XB_SPIN(xb_ld(&bar[XB_TOPGEN]) == tg, bar);
            __builtin_amdgcn_fence(__ATOMIC_ACQUIRE, "agent");
            xb_add(&bar[XB_XGEN(b.x)], 1u);
            asm volatile("s_waitcnt vmcnt(0)" ::: "memory");
        } else {
            XB_SPIN(xb_ld(&bar[XB_XGEN(b.x)]) == gen, bar);
            __builtin_amdgcn_fence(__ATOMIC_ACQUIRE, "agent");
            asm volatile("s_waitcnt vmcnt(0)" ::: "memory");
        }
    }
    __syncthreads();
}

struct Args { const float* in[25]; float* out; unsigned char* ws; int ph_lo, ph_hi; };
constexpr int NPHASES = 1 + 12 * NL;

__global__ void __launch_bounds__(NTHREADS, 2) fwd_kernel(Args args) {
    extern __shared__ __attribute__((aligned(16))) unsigned char lds_raw[];
    LAS unsigned char* lds = (LAS unsigned char*)lds_raw;
    cg::grid_group grid = cg::this_grid();
    const int G = gridDim.x, bid = blockIdx.x, NGW = G * NWAVES, GT = G * NTHREADS;
    float* X = args.out;
    LAS unsigned long long* ptab = (LAS unsigned long long*)(lds + 139264);
    if (threadIdx.x == 0) {
#pragma unroll
        for (int i = 0; i < 25; ++i) ptab[i] = (unsigned long long)args.in[i];
    }
    if (threadIdx.x < 2) ((volatile LAS unsigned*)(lds + 139264 + 256))[threadIdx.x] = 0u;
    __syncthreads();
    XcdBarrier xbar = xcd_barrier_post((unsigned*)args.ws, (volatile LAS unsigned*)(lds + 139264 + 256));

#pragma unroll 1
    for (int ph = args.ph_lo; ph < args.ph_hi; ++ph) {
        size_t zoff = 0; asm volatile("" : "+s"(zoff));
        unsigned char* wsb = args.ws + zoff;
        const int l = ph == 0 ? 0 : (ph - 1) / 12, k = ph == 0 ? -1 : (ph - 1) % 12;
#if defined(SKIP_MIX)
        if (k >= 3 && k <= 8) continue;
#endif
        if (k == -1) {
#if EN & 1
            { PH_IDX;
#if defined(DRY_THIN)
            PREP_FFN(3, 4, 0);
#endif
            PREP_FFN(3, 4, 0); PREP_MIX(0);
            rope_tables((const int*)rd_ptr(ptab, 1), COS_, SIN_, gtid, GT);
#if defined(DRY_THIN)
            { int dr_ = 1; asm volatile("" : "+s"(dr_)); norm_phase(rd_ptr(ptab, 0), nullptr, 0.f, nullptr, IN_L(2, 0, DM), X, WSP(bf16, WS_XN), gw, NGW, lane, dr_); }
#endif
            norm_phase(rd_ptr(ptab, 0), nullptr, 0.f, nullptr, IN_L(2, 0, DM), X, WSP(bf16, WS_XN), gw, NGW, lane);
            }
#endif
        } else if (k == 0 || k == 9) {
#if EN & 2
            pg8::Gemm g{WSP(bf16, WS_XN), WSP(bf16, WS_WF), M, 2 * DFF, DM}; pg8::StaticOrder S; S.init(M, 2 * DFF, G, bid);
            EpiSwiGLU E{MBP(bf16, MB_ACT)}; pg8::gemm_phase<EpiSwiGLU, pg8::StaticOrder, true, true>(lds, g, S, E);
#endif
        } else if (k == 1 || k == 10 || k == 7) {
#if EN & 4
            pg8::Gemm g{k == 7 ? MBP(bf16, MB_MIXB) : MBP(bf16, MB_ACT), k == 7 ? WM_OUT_ : WSP(bf16, WS_WF) + (size_t)2 * DFF * DM, M, DM, k == 7 ? DM : DFF}; pg8::StaticOrder S; S.init(M, DM, G, bid);
            EpiStore E{MBP(bf16, MB_H), DM}; pg8::gemm_phase<EpiStore, pg8::StaticOrder, true, true>(lds, g, S, E);
#endif
        } else if (k == 2) {
#if EN & 8
            { PH_IDX;
#if defined(DRY_THIN)
            { int dr_ = 1; asm volatile("" : "+s"(dr_)); norm_phase(X, MBP(bf16, MB_H), 0.5f, IN_L(5, l, DM), IN_L(6, l, DM), X, WSP(bf16, WS_XN), gw, NGW, lane, dr_); }
#endif
            norm_phase(X, MBP(bf16, MB_H), 0.5f, IN_L(5, l, DM), IN_L(6, l, DM), X, WSP(bf16, WS_XN), gw, NGW, lane);
#if defined(DRY_THIN)
            PREP_FFN(22, 23, l);
#endif
            PREP_FFN(22, 23, l);
            }
#endif
        } else if (k == 3) {
#if EN & 16
            { pg8::Gemm g{WSP(bf16, WS_XN), WM_IN_, M, 5120, DM}; pg8::StaticOrder S; S.init(M, 5120, G, bid); EpiSet1 E{wsb + WS_MB};
              pg8::gemm_phase<EpiSet1, pg8::StaticOrder, true, true>(lds, g, S, E); }
#endif
#if EN & 1024
            { pg8::Gemm g{WSP(bf16, WS_XN), WM_IN_ + (size_t)5120 * DM, M, 4096, DM}; pg8::StaticOrder S; S.init(M, 4096, G, bid); EpiSet2n E{wsb + WS_MB, COS_, SIN_};
              pg8::gemm_phase<EpiSet2n, pg8::StaticOrder, true, true>(lds, g, S, E); }
#endif
#if EN & 2048
            { pg8::Gemm g{WM_IN_ + (size_t)8192 * DM, WSP(bf16, WS_XN), 3072, M, DM}; pg8::StaticOrder S; S.init(3072, M, G, bid); EpiSet2t E{MBP(bf16, MB_KT), MBP(bf16, MB_VT), COS_, SIN_};
              pg8::gemm_phase<EpiSet2t, pg8::StaticOrder, true, true>(lds, g, S, E); }
#endif
        } else if (k == 4) {
#if EN & 32
            { PH_IDX;
#if defined(DRY_RET)
            { int dr = 1; asm volatile("" : "+s"(dr)); retention_phase(lds, MBP(bf16, MB_Q), MBP(bf16, MB_K), MBP(bf16, MB_KT), MBP(bf16, MB_VT), MBP(bf16, MB_G), WSP(float, WS_SS), bid, G, tid, dr); }
#endif
            retention_phase(lds, MBP(bf16, MB_Q), MBP(bf16, MB_K), MBP(bf16, MB_KT), MBP(bf16, MB_VT), MBP(bf16, MB_G), WSP(float, WS_SS), bid, G, tid);
            }
#endif
#if EN & 4096
            { PH_IDX;
            asm volatile("" ::: "memory"); __builtin_amdgcn_sched_barrier(0);
#if defined(DRY_LRU)
            lru_phase<false>(lds + wave * 16384, MBP(bf16, MB_XA), MBP(bf16, MB_YA), IN_L(8, l, 4 * DM), IN_L(9, l, DM), WAT_, WXT_, IN_L(11, l, DM), IN_L(13, l, DM), IN_L(14, l, DM), AGGA_, AGGH_, gw, NGW, lane);
#endif
            lru_phase<false>(lds + wave * 16384, MBP(bf16, MB_XA), MBP(bf16, MB_YA), IN_L(8, l, 4 * DM), IN_L(9, l, DM), WAT_, WXT_, IN_L(11, l, DM), IN_L(13, l, DM), IN_L(14, l, DM), AGGA_, AGGH_, gw, NGW, lane);
            }
#endif
#if EN & 8192
            { PH_IDX;
            asm volatile("" ::: "memory"); __builtin_amdgcn_sched_barrier(0);
#if defined(DRY_THIN)
            { int dr_ = 1; asm volatile("" : "+s"(dr_)); ac_phase(MBP(bf16, MB_SB), MBP(bf16, MB_SCSH), IN_L(17, l, 3 * DM), gtid, GT, dr_); }
#endif
            ac_phase(MBP(bf16, MB_SB), MBP(bf16, MB_SCSH), IN_L(17, l, 3 * DM), gtid, GT);
            }
#endif
        } else if (k == 5) {
#if EN & 64
            { PH_IDX;
#if defined(DRY_LRU)
            { int dr = 1; asm volatile("" : "+s"(dr)); lru_phase<true>(lds + wave * 16384, MBP(bf16, MB_XA), MBP(bf16, MB_YA), IN_L(8, l, 4 * DM), IN_L(9, l, DM), WAT_, WXT_, IN_L(11, l, DM), IN_L(13, l, DM), IN_L(14, l, DM), AGGA_, AGGH_, gw, NGW, lane, dr); }
#endif
            lru_phase<true>(lds + wave * 16384, MBP(bf16, MB_XA), MBP(bf16, MB_YA), IN_L(8, l, 4 * DM), IN_L(9, l, DM), WAT_, WXT_, IN_L(11, l, DM), IN_L(13, l, DM), IN_L(14, l, DM), AGGA_, AGGH_, gw, NGW, lane);
            }
#endif
#if EN & 16384
            { PH_IDX;
            asm volatile("" ::: "memory"); __builtin_amdgcn_sched_barrier(0);
#if defined(DRY_THIN)
            { int dr_ = 1; asm volatile("" : "+s"(dr_)); retnorm_phase(MBP(bf16, MB_G), WSP(float, WS_SS), gw, NGW, lane, dr_); }
#endif
            retnorm_phase(MBP(bf16, MB_G), WSP(float, WS_SS), gw, NGW, lane);
            __syncthreads();
            }
#endif
#if EN & 32768
            pg8::Gemm g{WSP(bf16, WS_XN), WM_IN_ + (size_t)11264 * DM, M, 3072, DM}; pg8::StaticOrder S; S.init(M, 3072, G, bid); EpiGates E{MBP(bf16, MB_GATES)};
            pg8::gemm_phase<EpiGates, pg8::StaticOrder, true, true>(lds, g, S, E);
#endif
        } else if (k == 6) {
#if EN & 128
#pragma unroll 1
            for (int c = 0; c < 3; ++c) {
#if defined(DIAG) && DIAG < 4
                if (c != DIAG - 1) continue;
#endif
#if defined(SKIPC)
                if (c == SKIPC) continue;
#endif
                pg8::Gemm g{c == 0 ? MBP(bf16, MB_YA) : (c == 1 ? MBP(bf16, MB_SB) : MBP(bf16, MB_G)), c == 0 ? WM_LRU_ : (c == 1 ? WM_SC_ : WM_RET_), M, DM, c == 2 ? 2048 : DM}; pg8::StaticOrder S; S.init(M, DM, G, bid);
                EpiMix E{MBP(bf16, MB_GATES), MBP(float, MB_MIX), MBP(bf16, MB_MIXB), c == 0 ? 0 : (c == 1 ? 2048 : 1024),
#if defined(DIAG)
                    3
#elif defined(SKIPC)
                    (SKIPC == 0 ? (c == 1 ? 0 : 2) : (SKIPC == 1 ? (c == 0 ? 0 : 2) : (c == 0 ? 0 : 4)))
#else
                    c
#endif
                };
                pg8::gemm_phase<EpiMix, pg8::StaticOrder, true, true>(lds, g, S, E);
#if defined(MIX_FENCE)
                __builtin_amdgcn_fence(__ATOMIC_SEQ_CST, "agent");
#endif
                __syncthreads();
            }
#endif
        } else if (k == 8) {
#if EN & 256
            { PH_IDX;
#if defined(DRY_THIN)
            { int dr_ = 1; asm volatile("" : "+s"(dr_)); norm_phase(X, MBP(bf16, MB_H), 1.0f, IN_L(20, l, DM), IN_L(21, l, DM), X, WSP(bf16, WS_XN), gw, NGW, lane, dr_); }
#endif
            norm_phase(X, MBP(bf16, MB_H), 1.0f, IN_L(20, l, DM), IN_L(21, l, DM), X, WSP(bf16, WS_XN), gw, NGW, lane);
            }
#endif
        } else if (k == 11) {
#if EN & 512
            { PH_IDX;
            if (l + 1 < NL) {
#if defined(DRY_THIN)
            { int dr_ = 1; asm volatile("" : "+s"(dr_)); norm_phase(X, MBP(bf16, MB_H), 0.5f, IN_L(24, l, DM), IN_L(2, l + 1, DM), X, WSP(bf16, WS_XN), gw, NGW, lane, dr_); }
#endif
                norm_phase(X, MBP(bf16, MB_H), 0.5f, IN_L(24, l, DM), IN_L(2, l + 1, DM), X, WSP(bf16, WS_XN), gw, NGW, lane);
#if defined(DRY_THIN)
                PREP_FFN(3, 4, l + 1);
#endif
                PREP_FFN(3, 4, l + 1); PREP_MIX(l + 1);
            } else norm_phase(X, MBP(bf16, MB_H), 0.5f, IN_L(24, l, DM), nullptr, X, WSP(bf16, WS_XN), gw, NGW, lane);
            }
#endif
        }
        if (ph + 1 < args.ph_hi) { if (args.ph_hi > NPHASES) grid.sync(); else xcd_barrier(xbar); }
#if defined(CHECK)
        {
            int stage = -1;
            if (ph == 0) stage = 0; else if (ph == 4) stage = 1; else if (ph == 5) stage = 2; else if (ph == 6) stage = 3; else if (ph == 7) stage = 4; else if (ph == 8) stage = 5;
            if (stage >= 0) {
                PH_IDX;
                float* DB = (float*)(wsb + WS_END);
                if (stage == 0) DB[gtid] = 0.f;
                ChkP P; P.pt = ptab; P.wsb = wsb; P.DB = DB;
                chk_stage(P, stage, gtid);
                if (stage == 5) {
                    grid.sync();
                    for (size_t i = gtid; i < (size_t)M * DM; i += GT) X[i] = 0.f;
                    grid.sync();
                    X[(size_t)gtid * 128] = DB[gtid];
                    if (gtid == 0) X[1] = 3000.f;
                    return;
                }
                grid.sync();
            }
        }
#endif
    }
}

#ifndef ONE_LAUNCH
#define ONE_LAUNCH 1
#endif
extern "C" void kernel_launch(void* const* d_in, const int* in_sizes, int n_in, void* d_out, int out_size, void* d_ws, size_t ws_size, hipStream_t stream) {
    static int ready = 0;
    if (ready == 0) {
        if (n_in != 25 || out_size != M * DM || ws_size < WS_END + 512 * KiB) { fprintf(stderr, "kernel_launch: unexpected problem (n_in %d out %d ws %zu need %zu)\n", n_in, out_size, ws_size, (size_t)WS_END); ready = -1; return; }
        if (hipFuncSetAttribute((const void*)fwd_kernel, hipFuncAttributeMaxDynamicSharedMemorySize, LDS_BYTES) != hipSuccess) { fprintf(stderr, "kernel_launch: hipFuncSetAttribute failed\n"); ready = -1; return; }
        int dev = 0, cus = 0, per_cu = 0;
        hipGetDevice(&dev); hipDeviceGetAttribute(&cus, hipDeviceAttributeMultiprocessorCount, dev);
        hipOccupancyMaxActiveBlocksPerMultiprocessor(&per_cu, (const void*)fwd_kernel, NTHREADS, LDS_BYTES);
        if (per_cu < 1) { fprintf(stderr, "kernel_launch: occupancy query says %d blocks per CU\n", per_cu); }
        (void)hipGetLastError();
        ready = cus > 0 ? cus : 256;
    }
    if (ready < 0) return;
    Args a{};
    for (int i = 0; i < 25; ++i) a.in[i] = (const float*)d_in[i];
    a.out = (float*)d_out; a.ws = (unsigned char*)d_ws;
#if ONE_LAUNCH
    (void)hipMemsetAsync(d_ws, 0, 64 * 1024, stream);
    a.ph_lo = 0; a.ph_hi = NPHASES;
    void* kargs[] = {&a};
    hipError_t e = hipLaunchCooperativeKernel((const void*)fwd_kernel, dim3(ready), dim3(NTHREADS), kargs, LDS_BYTES, stream);
    if (e != hipSuccess) fprintf(stderr, "cooperative launch failed: %s\n", hipGetErrorString(e));
#else
    for (int ph = 0; ph < NPHASES; ++ph) { a.ph_lo = ph; a.ph_hi = ph + 1; hipLaunchKernelGGL(fwd_kernel, dim3(ready), dim3(NTHREADS), LDS_BYTES, stream, a); }
#endif
}
```
